# Optimizing an MI355X kernel written in HIP

```python
import math
import jax, jax.numpy as jnp
from jax import lax
import numpy as np

D_MODEL = 1024
BATCH = 8
SEQ = 4096
DEPTH = 2
DEC_BATCH = 16
DEC_SEQ = 64
PAST_LEN = 2048

CHUNK = 64
MLP_CHUNK = 128
D_A = D_MODEL
N_GROUPS = 4
GROUP_W = D_A // N_GROUPS
N_HEADS = 8
HEAD_DIM = 64
V_DIM = 2 * HEAD_DIM
QK_W = N_HEADS * 2 * HEAD_DIM
D_B = N_HEADS * V_DIM
Q_BLOCK = 128
EPS = 1e-6
IN_SIZES = (D_A, D_A, D_A, QK_W, QK_W, D_B, D_B, D_MODEL, D_MODEL)
D_IN = D_A * 3 + QK_W * 2 + D_B * 2 + D_MODEL * 2

kernel_name = "gated_chunkmlp_diffattn_stream_step"


def rmsnorm(x, g):
    xf = x.astype(jnp.float32)
    y = xf * lax.rsqrt(jnp.mean(xf * xf, axis=-1, keepdims=True) + EPS)
    return (y * g.astype(jnp.float32)).astype(x.dtype)


def split_in(z):
    idx = []
    acc = 0
    for s in IN_SIZES[:-1]:
        acc += s
        idx.append(acc)
    return jnp.split(z, idx, axis=-1)


def masked_spatial(w_s):
    tril = jnp.tril(jnp.ones((MLP_CHUNK, MLP_CHUNK), dtype=bool))
    return jnp.where(tril[None], w_s, jnp.zeros_like(w_s))


def chunk_mlp_prompt(v, w_s, b_s):
    B, S, _ = v.shape
    n = S // MLP_CHUNK
    vr = v.reshape(B, n, MLP_CHUNK, N_GROUPS, GROUP_W)
    s = jnp.einsum('gts,bnsgc->bntgc', masked_spatial(w_s), vr)
    s = s + jnp.transpose(b_s)[None, None, :, :, None]
    return s.reshape(B, S, D_A)


def chunk_mlp_sample(v, w_s, b_s):
    B, L, _ = v.shape
    ws = masked_spatial(w_s)[:, :L, :L]
    vr = v.reshape(B, L, N_GROUPS, GROUP_W)
    s = jnp.einsum('gts,bsgc->btgc', ws, vr) + jnp.transpose(b_s[:, :L])[None, :, :, None]
    return s.reshape(B, L, D_A)


def diff_attn_core(q, k, v, lam, mask):
    scale = HEAD_DIM ** -0.5
    s = jnp.einsum('bqhjd,bkhjd->bhjqk', q, k).astype(jnp.float32) * scale
    if mask is not None:
        s = jnp.where(mask[None, None, None], s, jnp.float32(-1e30))
    p = jax.nn.softmax(s, axis=-1)
    a = p[:, :, 0] - lam * p[:, :, 1]
    return jnp.einsum('bhqk,bkhe->bqhe', a.astype(v.dtype), v)


def diff_attn_prompt(q, k, v, lam):
    B, S = q.shape[0], q.shape[1]
    nb = S // Q_BLOCK
    qb = jnp.moveaxis(q.reshape(B, nb, Q_BLOCK, N_HEADS, 2, HEAD_DIM), 1, 0)
    kpos = jnp.arange(S)

    def one_block(args):
        q_blk, blk = args
        qpos = blk * Q_BLOCK + jnp.arange(Q_BLOCK)
        mask = (kpos[None, :] // CHUNK) <= (qpos[:, None] // CHUNK)
        return diff_attn_core(q_blk, k, v, lam, mask)

    o = lax.map(one_block, (qb, jnp.arange(nb)))
    return jnp.moveaxis(o, 0, 1).reshape(B, S, N_HEADS, V_DIM)


def mixer_layer(x, li, norm_g, w_in, w_s, b_s, v_norm_g, lam_q1, lam_k1, lam_q2, lam_k2,
                attn_norm_g, w_pa, w_pb, w_out, cache_k=None, cache_v=None):
    B, L, _ = x.shape
    h = rmsnorm(x, norm_g)
    a_u, a_v, a_z, b_q, b_k, b_v, b_z, g_a, g_b = split_in(h @ w_in)
    a_u = jax.nn.gelu(a_u)
    a_v = rmsnorm(jax.nn.gelu(a_v), v_norm_g)
    if cache_k is None:
        spatial = chunk_mlp_prompt(a_v, w_s, b_s)
    else:
        spatial = chunk_mlp_sample(a_v, w_s, b_s)
    y_a = jax.nn.silu(a_z) * (a_u * spatial)
    q = b_q.reshape(B, L, N_HEADS, 2, HEAD_DIM)
    k = b_k.reshape(B, L, N_HEADS, 2, HEAD_DIM)
    v = b_v.reshape(B, L, N_HEADS, V_DIM)
    lam_init = 0.8 - 0.6 * math.exp(-0.3 * li)
    lam = (jnp.exp(jnp.sum(lam_q1.astype(jnp.float32) * lam_k1.astype(jnp.float32)))
           - jnp.exp(jnp.sum(lam_q2.astype(jnp.float32) * lam_k2.astype(jnp.float32)))
           + lam_init)
    if cache_k is None:
        o = diff_attn_prompt(q, k, v, lam)
    else:
        P = cache_k.shape[1]
        k_all = jnp.concatenate([cache_k.reshape(B, P, N_HEADS, 2, HEAD_DIM), k], axis=1)
        v_all = jnp.concatenate([cache_v, v], axis=1)
        o = diff_attn_core(q, k_all, v_all, lam, None)
    o = rmsnorm(o, attn_norm_g) * (1.0 - lam_init)
    y_b = jax.nn.silu(b_z) * o.reshape(B, L, D_B)
    merged = jax.nn.sigmoid(g_a) * (y_a @ w_pa) + jax.nn.sigmoid(g_b) * (y_b @ w_pb)
    x = x + merged @ w_out
    return x, k.reshape(B, L, N_HEADS, 2 * HEAD_DIM), v, a_v


def setup_inputs(seed: int = 0) -> dict:
    key = jax.random.key(seed)
    ks = jax.random.split(key, 20)
    nrm = jax.random.normal
    f32 = jnp.float32
    return {
        "x_prompt": nrm(ks[0], (BATCH, SEQ, D_MODEL), f32),
        "x_sample": nrm(ks[1], (DEC_BATCH, DEC_SEQ, D_MODEL), f32),
        "cache_k": nrm(ks[2], (DEPTH, DEC_BATCH, PAST_LEN, N_HEADS, 2 * HEAD_DIM), f32),
        "cache_v": nrm(ks[3], (DEPTH, DEC_BATCH, PAST_LEN, N_HEADS, V_DIM), f32),
        "norm_g": 1.0 + 0.01 * nrm(ks[4], (DEPTH, D_MODEL), f32),
        "w_in": nrm(ks[5], (DEPTH, D_MODEL, D_IN), f32) * D_MODEL ** -0.5,
        "w_s": nrm(ks[6], (DEPTH, N_GROUPS, MLP_CHUNK, MLP_CHUNK), f32) * (0.5 * MLP_CHUNK ** -0.5),
        "b_s": 1.0 + 0.01 * nrm(ks[7], (DEPTH, N_GROUPS, MLP_CHUNK), f32),
        "v_norm_g": 1.0 + 0.01 * nrm(ks[8], (DEPTH, D_A), f32),
        "lam_q1": 0.1 * nrm(ks[9], (DEPTH, HEAD_DIM), f32),
        "lam_k1": 0.1 * nrm(ks[10], (DEPTH, HEAD_DIM), f32),
        "lam_q2": 0.1 * nrm(ks[11], (DEPTH, HEAD_DIM), f32),
        "lam_k2": 0.1 * nrm(ks[12], (DEPTH, HEAD_DIM), f32),
        "attn_norm_g": 1.0 + 0.01 * nrm(ks[13], (DEPTH, V_DIM), f32),
        "w_pa": nrm(ks[14], (DEPTH, D_A, D_MODEL), f32) * D_A ** -0.5,
        "w_pb": nrm(ks[15], (DEPTH, D_B, D_MODEL), f32) * D_B ** -0.5,
        "w_out": nrm(ks[16], (DEPTH, D_MODEL, D_MODEL), f32) * D_MODEL ** -0.5,
        "final_norm_g": 1.0 + 0.01 * nrm(ks[17], (D_MODEL,), f32),
    }


def reference(x_prompt, x_sample, cache_k, cache_v, norm_g, w_in, w_s, b_s, v_norm_g,
              lam_q1, lam_k1, lam_q2, lam_k2, attn_norm_g, w_pa, w_pb, w_out, final_norm_g):
    xp, xs = x_prompt, x_sample
    kp_l, vp_l, ks_l, vs_l, as_l = [], [], [], [], []
    for li in range(DEPTH):
        w = (norm_g[li], w_in[li], w_s[li], b_s[li], v_norm_g[li], lam_q1[li], lam_k1[li],
             lam_q2[li], lam_k2[li], attn_norm_g[li], w_pa[li], w_pb[li], w_out[li])
        xp, kp, vp, _ = mixer_layer(xp, li, *w)
        xs, ks_, vs_, as_ = mixer_layer(xs, li, *w, cache_k=cache_k[li], cache_v=cache_v[li])
        kp_l.append(kp); vp_l.append(vp)
        ks_l.append(ks_); vs_l.append(vs_); as_l.append(as_)
    y_prompt = rmsnorm(xp, final_norm_g)
    y_sample = rmsnorm(xs, final_norm_g)
    new_k_prompt = jnp.stack(kp_l, axis=0)
    new_v_prompt = jnp.stack(vp_l, axis=0)
    new_k_sample = jnp.stack(ks_l, axis=0)
    new_v_sample = jnp.stack(vs_l, axis=0)
    new_mlpv_sample = jnp.stack(as_l, axis=0)
    return (y_prompt, y_sample, new_k_prompt, new_v_prompt, new_k_sample, new_v_sample, new_mlpv_sample)
```

```cpp
#include <hip/hip_runtime.h>
#include <hip/hip_cooperative_groups.h>
#include <cstdio>
#include <cstdint>
namespace cg = cooperative_groups;
namespace pg8 {
#define PG8_LAS __attribute__((address_space(3)))
typedef unsigned short bf16_t;
typedef short bf16x8 __attribute__((ext_vector_type(8)));
typedef float f32x4 __attribute__((ext_vector_type(4)));
typedef unsigned u32x4 __attribute__((ext_vector_type(4)));
constexpr int BM = 256, BK = 64, HALF = 128, HTB = HALF * BK * 2  , STAGE_BYTES = 8 * HTB, NXCD = 8, WGM = 8;

__host__ __device__ __forceinline__ int lds_byte(int r, int c) { const int st = (r >> 4) * 2 + (c >> 5), rr = r & 15, cc = c & 31, ob = rr * 64 + cc * 2; return st * 1024 + (ob ^ (((ob >> 9) & 1) << 5)); }
__host__ __device__ __forceinline__ void stage_rc(int b, int& R, int& C) { const int st = b / 1024, sb = b % 1024, swz = sb ^ (((sb >> 9) & 1) << 5); R = (st >> 1) * 16 + swz / 64; C = (st & 1) * 32 + (swz % 64) / 2; }
__host__ __device__ __forceinline__ int perm32(int rho) { const int n = rho >> 4, i = rho & 15; return 8 * (i >> 2) + 4 * n + (i & 3); }

struct Unit { int pm, pn; };
struct Gemm { const bf16_t* A; const bf16_t* Bt; int M, N, K; };

struct StaticOrder {
    int nM, nN, nwg, G, c;
    __host__ __device__ void init(int M, int N, int G_, int c_) { nM = M / BM; nN = N / BM; nwg = nM * nN; G = G_; c = c_; }
    __host__ __device__ bool next(int i, Unit& u) const {
        const long L = (long)i * G + c; if (L >= nwg) return false;
        int wgid = (int)L; { const int q = nwg / NXCD, r = nwg % NXCD, xcd = wgid % NXCD, off = wgid / NXCD; wgid = (xcd < r ? xcd * (q + 1) : r * (q + 1) + (xcd - r) * q) + off; }
        const int nig = WGM * nN, gid = wgid / nig, fm = gid * WGM, gsz = (nM - fm) < WGM ? (nM - fm) : WGM;
        u.pm = fm + ((wgid % nig) % gsz); u.pn = (wgid % nig) / gsz; return true;
    }
    __device__ __forceinline__ void a_ready(const Unit&) const {}
    __device__ __forceinline__ void done(const Unit&) const {}
};

typedef float f32x2 __attribute__((ext_vector_type(2)));
typedef float f32x2cv __attribute__((ext_vector_type(2))); typedef __bf16 bf16x2cv __attribute__((ext_vector_type(2)));
__device__ __forceinline__ unsigned cvt_pk_bf16(float lo, float hi) { const f32x2cv v = {lo, hi}; const bf16x2cv b = __builtin_convertvector(v, bf16x2cv); return __builtin_bit_cast(unsigned, b); }

#ifndef EPI_DRAIN_N
#define EPI_DRAIN_N 8
#endif
#define PG8_STR2(x) #x
#define PG8_STR(x) PG8_STR2(x)
#define EPI_DRAIN() asm volatile("s_waitcnt vmcnt(0)" ::: "memory")
template <class Epi, class Sched, bool ALIGN_EPI = false, bool SP2 = false>
__device__ __forceinline__ void gemm_phase(PG8_LAS unsigned char* lds, const Gemm g, const Sched& S, const Epi& E) {
    int tid_ = threadIdx.x; asm volatile("" : "+v"(tid_)); const int tid = tid_, wid = __builtin_amdgcn_readfirstlane(tid >> 6), lane = tid & 63, wr = wid >> 2, wc = wid & 3, fr = lane & 15, fq = lane >> 4;
    const int K = g.K, nt = K / BK;
    unsigned voffA[2], voffB[2];
#pragma unroll
    for (int i = 0; i < 2; ++i) { int R, C; stage_rc(tid * 16 + i * 8192, R, C); const int Rb = Epi::PERM ? ((R & ~31) + perm32(R & 31)) : R;
        voffA[i] = (unsigned)(R * K + C) * 2u; voffB[i] = (unsigned)(Rb * K + C) * 2u; }
    const size_t kstep = (size_t)(BK * 2);
    const size_t hstep = (size_t)HALF * K * 2;
    const size_t tstep = 2 * hstep;
    const unsigned ldsw = (unsigned)wid * 1024u;
    const int aoff = lds_byte(wr * 64 + fr, fq * 8), boff = lds_byte(wc * 32 + fr, fq * 8);
#define PG8_SA(b, h) (((b) * 2 + (h)) * HTB)
#define PG8_SB(b, h) ((4 + (b) * 2 + (h)) * HTB)
#define PG8_STAGE(bufoff, gbase, voff) do { _Pragma("unroll") for (int _i = 0; _i < 2; ++_i) \
        __builtin_amdgcn_global_load_lds((const unsigned*)((const char*)(gbase) + (voff)[_i]), (PG8_LAS unsigned*)(lds + (bufoff) + ldsw + _i * 8192), 16, 0, 0); } while (0)
#define PG8_LDA(dst, b, h) do { _Pragma("unroll") for (int m = 0; m < 4; ++m) _Pragma("unroll") for (int k = 0; k < 2; ++k) dst[m][k] = *(const PG8_LAS bf16x8*)(lds + PG8_SA(b, h) + aoff + m * 2048 + k * 1024); } while (0)
#define PG8_LDB(dst, b, h) do { _Pragma("unroll") for (int n = 0; n < 2; ++n) _Pragma("unroll") for (int k = 0; k < 2; ++k) dst[n][k] = *(const PG8_LAS bf16x8*)(lds + PG8_SB(b, h) + boff + n * 2048 + k * 1024); } while (0)
#define PG8_MMA(ai, bj, At, Bt) do { __builtin_amdgcn_s_setprio(1); _Pragma("unroll") for (int m = 0; m < 4; ++m) _Pragma("unroll") for (int n = 0; n < 2; ++n) _Pragma("unroll") for (int k = 0; k < 2; ++k) \
        acc[ai][bj][m][n] = __builtin_amdgcn_mfma_f32_16x16x32_bf16(Bt[n][k], At[m][k], acc[ai][bj][m][n], 0, 0, 0); __builtin_amdgcn_s_setprio(0); } while (0)
#define PG8_WAIT_V(n) asm volatile("s_waitcnt vmcnt(" #n ")" ::: "memory")
#define PG8_WAIT_L(n) asm volatile("s_waitcnt lgkmcnt(" #n ")" ::: "memory")
#define PG8_BAR __builtin_amdgcn_s_barrier()
#define PG8_SCHED __builtin_amdgcn_sched_barrier(0)
    Unit cur, nxt; int ui = 0;
    if (!S.next(0, cur)) return;
    f32x4 acc[2][2][4][2];
#pragma unroll
    for (int a = 0; a < 2; ++a)
#pragma unroll
        for (int b = 0; b < 2; ++b)
#pragma unroll
            for (int m = 0; m < 4; ++m)
#pragma unroll
                for (int n = 0; n < 2; ++n) acc[a][b][m][n] = (f32x4){0.f, 0.f, 0.f, 0.f};
    bf16x8 At[4][2], B0[2][2], B1[2][2];
    const char* cA = (const char*)g.A + (size_t)cur.pm * tstep; const char* cB = (const char*)g.Bt + (size_t)cur.pn * tstep;
    S.a_ready(cur);
    if constexpr (SP2) {
        PG8_STAGE(PG8_SB(0, 0), cB, voffB); PG8_STAGE(PG8_SB(0, 1), cB + hstep, voffB); PG8_STAGE(PG8_SA(0, 0), cA, voffA); PG8_STAGE(PG8_SA(0, 1), cA + hstep, voffA);
        if (wr == 1) PG8_BAR;
        PG8_WAIT_V(2); PG8_BAR;
        PG8_STAGE(PG8_SB(1, 0), cB + kstep, voffB); PG8_STAGE(PG8_SA(1, 0), cA + kstep, voffA); PG8_STAGE(PG8_SB(1, 1), cB + hstep + kstep, voffB);
        PG8_WAIT_V(6); PG8_BAR;
    } else {
        PG8_STAGE(PG8_SB(0, 0), cB, voffB); PG8_STAGE(PG8_SA(0, 0), cA, voffA); PG8_STAGE(PG8_SB(0, 1), cB + hstep, voffB); PG8_STAGE(PG8_SA(0, 1), cA + hstep, voffA);
        if (wr == 1) PG8_BAR;
        PG8_WAIT_V(4); PG8_BAR;
        PG8_STAGE(PG8_SB(1, 0), cB + kstep, voffB); PG8_STAGE(PG8_SA(1, 0), cA + kstep, voffA); PG8_STAGE(PG8_SB(1, 1), cB + hstep + kstep, voffB);
        PG8_WAIT_V(6); PG8_BAR;
    }
    for (;;) {
        const bool has_next = S.next(ui + 1, nxt);
        const char* nA = has_next ? (const char*)g.A + (size_t)nxt.pm * tstep : cA; const char* nB = has_next ? (const char*)g.Bt + (size_t)nxt.pn * tstep : cB;
        for (int t = 0; t < nt; t += 2) {
            const bool last = (t == nt - 2);
            const char* a1 = cA + (size_t)(t + 1) * kstep;
            const char* a2 = last ? nA : cA + (size_t)(t + 2) * kstep; const char* b2 = last ? nB : cB + (size_t)(t + 2) * kstep;
            const char* a3 = a2 + kstep; const char* b3 = b2 + kstep;
            if (last && has_next) S.a_ready(nxt);
            if constexpr (SP2) {
            PG8_LDB(B0, 0, 0); PG8_LDB(B1, 0, 1); PG8_SCHED; PG8_LDA(At, 0, 0); PG8_STAGE(PG8_SA(1, 1), a1 + hstep, voffA);
            PG8_WAIT_V(8); PG8_WAIT_L(0); PG8_BAR; PG8_MMA(0, 0, At, B0); PG8_MMA(0, 1, At, B1); PG8_BAR; PG8_SCHED;
            PG8_LDA(At, 0, 1); PG8_STAGE(PG8_SB(0, 0), b2, voffB); PG8_STAGE(PG8_SB(0, 1), b2 + hstep, voffB); PG8_STAGE(PG8_SA(0, 0), a2, voffA);
            PG8_WAIT_V(8); PG8_WAIT_L(0); PG8_BAR; PG8_MMA(1, 0, At, B0); PG8_MMA(1, 1, At, B1); PG8_BAR; PG8_SCHED;
            PG8_LDB(B0, 1, 0); PG8_LDB(B1, 1, 1); PG8_SCHED; PG8_LDA(At, 1, 0); PG8_STAGE(PG8_SA(0, 1), a2 + hstep, voffA);
            PG8_WAIT_V(8); PG8_WAIT_L(0); PG8_BAR; PG8_MMA(0, 0, At, B0); PG8_MMA(0, 1, At, B1); PG8_BAR; PG8_SCHED;
            PG8_LDA(At, 1, 1); PG8_STAGE(PG8_SB(1, 0), b3, voffB); PG8_STAGE(PG8_SB(1, 1), b3 + hstep, voffB); PG8_STAGE(PG8_SA(1, 0), a3, voffA);
            PG8_WAIT_V(8); PG8_WAIT_L(0); PG8_BAR; PG8_MMA(1, 0, At, B0); PG8_MMA(1, 1, At, B1); PG8_BAR; PG8_SCHED;
            } else {
            PG8_LDB(B0, 0, 0); PG8_SCHED; PG8_LDA(At, 0, 0); PG8_STAGE(PG8_SA(1, 1), a1 + hstep, voffA);
            PG8_WAIT_L(8); PG8_BAR; PG8_WAIT_L(0); PG8_MMA(0, 0, At, B0); PG8_BAR; PG8_SCHED;
            PG8_LDB(B1, 0, 1); PG8_STAGE(PG8_SB(0, 0), b2, voffB);
            PG8_BAR; PG8_WAIT_L(0); PG8_MMA(0, 1, At, B1); PG8_BAR;
            PG8_LDA(At, 0, 1); PG8_STAGE(PG8_SA(0, 0), a2, voffA);
            PG8_BAR; PG8_WAIT_L(0); PG8_MMA(1, 0, At, B0); PG8_BAR; PG8_SCHED;
            PG8_STAGE(PG8_SB(0, 1), b2 + hstep, voffB);
            PG8_WAIT_V(6); PG8_BAR; PG8_MMA(1, 1, At, B1); PG8_BAR;
            PG8_LDB(B0, 1, 0); PG8_SCHED; PG8_LDA(At, 1, 0); PG8_STAGE(PG8_SA(0, 1), a2 + hstep, voffA);
            PG8_WAIT_L(8); PG8_BAR; PG8_WAIT_L(0); PG8_MMA(0, 0, At, B0); PG8_BAR; PG8_SCHED;
            PG8_LDB(B1, 1, 1); PG8_STAGE(PG8_SB(1, 0), b3, voffB);
            PG8_BAR; PG8_WAIT_L(0); PG8_MMA(0, 1, At, B1); PG8_BAR;
            PG8_LDA(At, 1, 1); PG8_STAGE(PG8_SA(1, 0), a3, voffA);
            PG8_BAR; PG8_WAIT_L(0); PG8_MMA(1, 0, At, B0); PG8_BAR; PG8_SCHED;
            PG8_STAGE(PG8_SB(1, 1), b3 + hstep, voffB);
            PG8_WAIT_V(6); PG8_BAR; PG8_MMA(1, 1, At, B1); PG8_BAR;
            }
        }
        if constexpr (ALIGN_EPI) { if (wr == 0) PG8_BAR; }
        if constexpr (!Epi::AFTER_DRAIN) { E(acc, cur, wr, wc, fr, fq); S.done(cur); }
        if (!has_next) break;
#pragma unroll
        for (int a = 0; a < 2; ++a)
#pragma unroll
            for (int b = 0; b < 2; ++b)
#pragma unroll
                for (int m = 0; m < 4; ++m)
#pragma unroll
                    for (int n = 0; n < 2; ++n) acc[a][b][m][n] = (f32x4){0.f, 0.f, 0.f, 0.f};
        cur = nxt; cA = nA; cB = nB; ++ui;
        if constexpr (ALIGN_EPI) { if (wr == 1) PG8_BAR; }
    }
    PG8_WAIT_V(0);
    if constexpr (!ALIGN_EPI) { if (wr == 0) PG8_BAR; }
    PG8_BAR;
    if constexpr (Epi::AFTER_DRAIN) { E.fused(acc, cur, wr, wc, fr, fq, lds, wid, lane); S.done(cur); }
#undef PG8_SA
#undef PG8_SB
#undef PG8_STAGE
#undef PG8_LDA
#undef PG8_LDB
#undef PG8_MMA
#undef PG8_WAIT_V
#undef PG8_WAIT_L
#undef PG8_BAR
#undef PG8_SCHED
}
}
#define LAS __attribute__((address_space(3)))
typedef unsigned short bf16_t;
typedef short bf16x8 __attribute__((ext_vector_type(8)));
typedef short s16x4 __attribute__((ext_vector_type(4)));
typedef float f32x4 __attribute__((ext_vector_type(4)));
typedef float f32x16 __attribute__((ext_vector_type(16)));
typedef unsigned u32x4 __attribute__((ext_vector_type(4)));
typedef unsigned u32x2 __attribute__((ext_vector_type(2)));

constexpr int DM = 1024, NBATCH = 8, SEQ = 4096, DBATCH = 16, DSEQ = 64, PAST = 2048;
constexpr int MP = NBATCH * SEQ, MS = DBATCH * DSEQ, MT = MP + MS;
constexpr int DIN = 9216;
constexpr float EPS = 1e-6f;
constexpr float QSCALE = 0.125f * 1.4426950408889634f;
constexpr size_t ACT = (size_t)MT * DM;
constexpr size_t O_YP = 0, O_YS = (size_t)MP * DM, O_KP = O_YS + (size_t)MS * DM, O_VP = O_KP + 2 * (size_t)MP * DM,
                 O_KS = O_VP + 2 * (size_t)MP * DM, O_VS = O_KS + 2 * (size_t)MS * DM, O_MV = O_VS + 2 * (size_t)MS * DM;
constexpr size_t MiB = 1u << 20;
constexpr size_t WS_CTL = 0;
constexpr size_t WS_WIN = 1 * MiB, WS_WPA = 37 * MiB, WS_WPB = 41 * MiB, WS_WOUT = 45 * MiB, WS_WSB = 49 * MiB;
constexpr size_t WS_XB = 50 * MiB, WS_X1 = 116 * MiB, WS_ACT = 248 * MiB;
constexpr size_t ACT_BYTES = 66 * MiB;
constexpr size_t WS_PART = WS_ACT + 10 * ACT_BYTES;
constexpr size_t WS_XB1 = WS_PART + 16 * MiB;
constexpr size_t WS_END = WS_XB1 + 66 * MiB;
static_assert(ACT * 2 == ACT_BYTES, "act size");
enum { A_UZ = 0, A_AV, A_QB, A_KB, A_VB, A_BZ, A_SGA, A_SGB, A_YA, A_YB };
constexpr int LDS_BYTES = 135168;

__device__ __forceinline__ float bf2f(unsigned v) { return __uint_as_float(v << 16); }
__device__ __forceinline__ unsigned f2bf(float f) { unsigned u = __float_as_uint(f); return (u + 0x7fffu + ((u >> 16) & 1u)) >> 16; }
__device__ __forceinline__ unsigned pk2(float lo, float hi) { return pg8::cvt_pk_bf16(lo, hi); }
__device__ __forceinline__ float fexp2(float x) { return __builtin_amdgcn_exp2f(x); }
__device__ __forceinline__ float frcp(float x) { return __builtin_amdgcn_rcpf(x); }
__device__ __forceinline__ float sigm(float x) { return frcp(1.f + fexp2(-1.4426950409f * x)); }
__device__ __forceinline__ float silu(float x) { return x * sigm(x); }
__device__ __forceinline__ float gelu_t(float x) { const float u = x + 0.044715f * x * x * x; return x * frcp(1.f + fexp2(-2.3022082f * u)); }
__device__ __forceinline__ float gelu_silu(float u, float z) { const float w = u + 0.044715f * u * u * u; const float d = (1.f + fexp2(-2.3022082f * w)) * (1.f + fexp2(-1.4426950409f * z)); return (u * z) * frcp(d); }
__device__ __forceinline__ float wave_sum(float v) {
#pragma unroll
    for (int o = 1; o < 64; o <<= 1) v += __shfl_xor(v, o);
    return v;
}

namespace pg8 {
struct EpiIn {
    static constexpr bool PERM = true, AFTER_DRAIN = false;
    const float* xpart; float* avpart; bf16_t* act; float *kp, *vp, *ks, *vs;
    __device__ __forceinline__ float rinv_of(int row, int fq) const { const f32x4 q = *(const f32x4*)(xpart + ((size_t)fq * MT + row) * 4);     float s = (q[0] + q[1]) + (q[2] + q[3]); s += __shfl_xor(s, 16); s += __shfl_xor(s, 32); return __builtin_amdgcn_rsqf(s * (1.f / 1024.f) + EPS); }
    template <int SEC> __device__ __forceinline__ void body(const f32x4 (&acc)[2][2][4][2], const Unit& u, int rowb, int cb, int wc, int fq) const {
        bf16_t* dst = act + (size_t)(SEC + 1) * ACT;
#pragma unroll
        for (int ai = 0; ai < 2; ++ai)
#pragma unroll
            for (int m = 0; m < 4; ++m) {
                const int row = rowb + ai * HALF + m * 16;
                const float r = rinv_of(row, fq);
                float ssq = 0.f;
#pragma unroll
                for (int bj = 0; bj < 2; ++bj) {
                    f32x4 v0 = acc[ai][bj][m][0] * r, v1 = acc[ai][bj][m][1] * r;
                    const int col = cb + bj * HALF;
                    if (SEC == 0) {
#pragma unroll
                        for (int j = 0; j < 4; ++j) { v0[j] = gelu_t(v0[j]); v1[j] = gelu_t(v1[j]); ssq += v0[j] * v0[j] + v1[j] * v1[j]; }
                    } else if (SEC == 1) { v0 = v0 * QSCALE; v1 = v1 * QSCALE; }
                    else if (SEC == 2 || SEC == 3) {
                        float* o = (SEC == 2) ? (row < MP ? kp + (size_t)row * DM : ks + (size_t)(row - MP) * DM) : (row < MP ? vp + (size_t)row * DM : vs + (size_t)(row - MP) * DM);
                        *(f32x4*)(o + col) = v0; *(f32x4*)(o + col + 4) = v1;
                    } else if (SEC == 4) {
#pragma unroll
                        for (int j = 0; j < 4; ++j) { v0[j] = silu(v0[j]); v1[j] = silu(v1[j]); }
                    } else {
#ifndef RAW_GATE
#pragma unroll
                        for (int j = 0; j < 4; ++j) { v0[j] = sigm(v0[j]); v1[j] = sigm(v1[j]); }
#endif
                    }
                    u32x4 w; w.x = cvt_pk_bf16(v0[0], v0[1]); w.y = cvt_pk_bf16(v0[2], v0[3]); w.z = cvt_pk_bf16(v1[0], v1[1]); w.w = cvt_pk_bf16(v1[2], v1[3]);
                    *(u32x4*)(dst + (size_t)row * DM + col) = w;
                }
                if (SEC == 0) { ssq += __shfl_xor(ssq, 16); ssq += __shfl_xor(ssq, 32); if (fq == 0) avpart[((size_t)((u.pn - 8) & 3) * MT + row) * 4 + wc] = ssq; }
            }
    }
    __device__ __forceinline__ void operator()(const f32x4 (&acc)[2][2][4][2], const Unit& u, int wr, int wc, int fr, int fq) const {
        const int pn = u.pn, rowb = u.pm * BM + wr * 64 + fr, cl = wc * 32 + 8 * fq;
        if (pn < 8) {
#pragma unroll
            for (int ai = 0; ai < 2; ++ai)
#pragma unroll
                for (int m = 0; m < 4; ++m) {
                    const int row = rowb + ai * HALF + m * 16;
                    const float r = rinv_of(row, fq);
                    const f32x4 u0 = acc[ai][0][m][0] * r, u1 = acc[ai][0][m][1] * r, z0 = acc[ai][1][m][0] * r, z1 = acc[ai][1][m][1] * r;
                    f32x4 o0, o1;
#pragma unroll
                    for (int j = 0; j < 4; ++j) { o0[j] = gelu_silu(u0[j], z0[j]); o1[j] = gelu_silu(u1[j], z1[j]); }
                    u32x4 w; w.x = cvt_pk_bf16(o0[0], o0[1]); w.y = cvt_pk_bf16(o0[2], o0[3]); w.z = cvt_pk_bf16(o1[0], o1[1]); w.w = cvt_pk_bf16(o1[2], o1[3]);
                    *(u32x4*)(act + (size_t)row * DM + pn * HALF + cl) = w;
                }
        } else {
            const int sec = (pn - 8) >> 2, cb = ((pn - 8) & 3) * BM + cl;
            switch (sec) {
                case 0: body<0>(acc, u, rowb, cb, wc, fq); break;
                case 1: body<1>(acc, u, rowb, cb, wc, fq); break;
                case 2: body<2>(acc, u, rowb, cb, wc, fq); break;
                case 3: body<3>(acc, u, rowb, cb, wc, fq); break;
                case 4: body<4>(acc, u, rowb, cb, wc, fq); break;
                case 5: body<5>(acc, u, rowb, cb, wc, fq); break;
                default: body<6>(acc, u, rowb, cb, wc, fq); break;
            }
        }
    }
};
template <int MODE> struct EpiGate {
    static constexpr bool PERM = true, AFTER_DRAIN = false;
    const bf16_t* gate; const bf16_t* prev; bf16_t* out;
    __device__ __forceinline__ void operator()(const f32x4 (&acc)[2][2][4][2], const Unit& u, int wr, int wc, int fr, int fq) const {
        const int rowb = u.pm * BM + wr * 64 + fr, cb = u.pn * BM + wc * 32 + 8 * fq;
#pragma unroll
        for (int ai = 0; ai < 2; ++ai) {
            u32x4 gq[4][2], pq[4][2];
#pragma unroll
            for (int m = 0; m < 4; ++m)
#pragma unroll
                for (int bj = 0; bj < 2; ++bj) {
                    const size_t off = (size_t)(rowb + ai * HALF + m * 16) * DM + cb + bj * HALF;
                    gq[m][bj] = *(const u32x4*)(gate + off);
                    if (MODE == 1) pq[m][bj] = *(const u32x4*)(prev + off);
                }
#pragma unroll
            for (int m = 0; m < 4; ++m)
#pragma unroll
                for (int bj = 0; bj < 2; ++bj) {
                    const size_t off = (size_t)(rowb + ai * HALF + m * 16) * DM + cb + bj * HALF;
                    const u32x4 g = gq[m][bj];
                    f32x4 v0 = acc[ai][bj][m][0], v1 = acc[ai][bj][m][1];
                    v0[0] *= bf2f(g.x & 0xffffu); v0[1] *= bf2f(g.x >> 16); v0[2] *= bf2f(g.y & 0xffffu); v0[3] *= bf2f(g.y >> 16);
                    v1[0] *= bf2f(g.z & 0xffffu); v1[1] *= bf2f(g.z >> 16); v1[2] *= bf2f(g.w & 0xffffu); v1[3] *= bf2f(g.w >> 16);
                    if (MODE == 1) { const u32x4 q = pq[m][bj];
                        v0[0] += bf2f(q.x & 0xffffu); v0[1] += bf2f(q.x >> 16); v0[2] += bf2f(q.y & 0xffffu); v0[3] += bf2f(q.y >> 16);
                        v1[0] += bf2f(q.z & 0xffffu); v1[1] += bf2f(q.z >> 16); v1[2] += bf2f(q.w & 0xffffu); v1[3] += bf2f(q.w >> 16); }
                    u32x4 w; w.x = cvt_pk_bf16(v0[0], v0[1]); w.y = cvt_pk_bf16(v0[2], v0[3]); w.z = cvt_pk_bf16(v1[0], v1[1]); w.w = cvt_pk_bf16(v1[2], v1[3]);
                    *(u32x4*)(out + off) = w;
                }
            asm volatile("" ::: "memory");
        }
    }
};
struct EpiRes {
    static constexpr bool PERM = true, AFTER_DRAIN = false;
    const float* xp; const float* xs;
    float* x1; bf16_t* xb; float* ssq; int next;
    __device__ __forceinline__ void operator()(const f32x4 (&acc)[2][2][4][2], const Unit& u, int wr, int wc, int fr, int fq) const {
        const int rowb = u.pm * BM + wr * 64 + fr, cb = u.pn * BM + wc * 32 + 8 * fq;
#pragma unroll
        for (int ai = 0; ai < 2; ++ai) {
            f32x4 rq[4][2][2];
#pragma unroll
            for (int m = 0; m < 4; ++m) { const int row = rowb + ai * HALF + m * 16; const float* src = row < MP ? xp + (size_t)row * DM : xs + (size_t)(row - MP) * DM;
#pragma unroll
                for (int bj = 0; bj < 2; ++bj) { rq[m][bj][0] = *(const f32x4*)(src + cb + bj * HALF); rq[m][bj][1] = *(const f32x4*)(src + cb + bj * HALF + 4); } }
#pragma unroll
            for (int m = 0; m < 4; ++m) {
                const int row = rowb + ai * HALF + m * 16;
                float s = 0.f;
#pragma unroll
                for (int bj = 0; bj < 2; ++bj) {
                    const int col = cb + bj * HALF;
                    const f32x4 v0 = acc[ai][bj][m][0] + rq[m][bj][0], v1 = acc[ai][bj][m][1] + rq[m][bj][1];
                    *(f32x4*)(x1 + (size_t)row * DM + col) = v0; *(f32x4*)(x1 + (size_t)row * DM + col + 4) = v1;
                    if (next) {
                        u32x4 w; w.x = cvt_pk_bf16(v0[0], v0[1]); w.y = cvt_pk_bf16(v0[2], v0[3]); w.z = cvt_pk_bf16(v1[0], v1[1]); w.w = cvt_pk_bf16(v1[2], v1[3]);
                        *(u32x4*)(xb + (size_t)row * DM + col) = w;
#pragma unroll
                        for (int j = 0; j < 4; ++j) s += v0[j] * v0[j] + v1[j] * v1[j];
                    }
                }
                if (next) { s += __shfl_xor(s, 16); s += __shfl_xor(s, 32); if (fq == 0) ssq[((size_t)u.pn * MT + row) * 4 + wc] = s; }
            }
            asm volatile("" ::: "memory");
        }
    }
};
}
__device__ __forceinline__ void tr_item(const float* W, int N, int ncol0, int k0, const float* kscale, bf16_t* WTrow0, LAS float* scr, int lane) {
#pragma unroll 8
    for (int i = 0; i < 32; ++i) { const int kk = 2 * i + (lane >> 5); float v = W[(size_t)(k0 + kk) * N + ncol0 + (lane & 31)]; if (kscale) v *= kscale[k0 + kk]; scr[kk * 33 + (lane & 31)] = v; }
    asm volatile("s_waitcnt lgkmcnt(0)" ::: "memory");
    const int c = lane & 7;
#pragma unroll
    for (int j = 0; j < 4; ++j) { const int n = (lane >> 3) + 8 * j; const LAS float* s = scr + (8 * c) * 33 + n;
        u32x4 o; o.x = pk2(s[0 * 33], s[1 * 33]); o.y = pk2(s[2 * 33], s[3 * 33]); o.z = pk2(s[4 * 33], s[5 * 33]); o.w = pk2(s[6 * 33], s[7 * 33]);
        *(u32x4*)(WTrow0 + (size_t)n * DM + k0 + 8 * c) = o; }
    asm volatile("s_waitcnt lgkmcnt(0)" ::: "memory");
}
struct Params { const float* in[18]; float* out; unsigned char* ws; int ph_lo, ph_hi; };

typedef const __attribute__((address_space(4))) Params* KArgsP;
__device__ __forceinline__ void phase_prologue(KArgsP kp, LAS unsigned char* lds) {
    int tid_ = threadIdx.x; asm volatile("" : "+v"(tid_)); const int tid = tid_, lane = tid & 63, wave = tid >> 6, G = gridDim.x;
    const int gw = blockIdx.x * 8 + wave, NGW = G * 8;
    LAS float* scr = (LAS float*)(lds + wave * 8448);
    float* ctl = (float*)(kp->ws + WS_CTL);
    float* xpart = (float*)(kp->ws + WS_PART);
    constexpr int I_IN = 16 * 288, I_P = 16 * 32, I_L = I_IN + 3 * I_P;
    for (int it = gw; it < 2 * I_L; it += NGW) {
        const int li = it / I_L; int r = it % I_L;
        if (r < I_IN) {
            const int kb = r / 288, nb = r % 288, d0 = nb * 32;
            int src;
            if (d0 < 2048) { const int t = d0 >> 8, wi = d0 & 255; src = wi < 128 ? 128 * t + wi : 2048 + 128 * t + (wi - 128); }
            else if (d0 < 3072) src = d0 - 1024;
            else src = d0;
            tr_item(kp->in[5] + (size_t)li * DM * DIN, DIN, src, kb * 64, kp->in[4] + li * DM, (bf16_t*)(kp->ws + WS_WIN) + ((size_t)li * DIN + d0) * DM, scr, lane);
        } else {
            r -= I_IN; const int which = r / I_P; r %= I_P; const int kb = r / 32, nb = r % 32;
            const float* W = kp->in[14 + which] + (size_t)li * DM * DM;
            bf16_t* WT = (bf16_t*)(kp->ws + (which == 0 ? WS_WPA : which == 1 ? WS_WPB : WS_WOUT)) + ((size_t)li * DM + nb * 32) * DM;
            tr_item(W, DM, nb * 32, kb * 64, nullptr, WT, scr, lane);
        }
    }
    bf16_t* XB = (bf16_t*)(kp->ws + WS_XB);
    for (int m = gw; m < MT; m += NGW) {
        const float* xr = m < MP ? kp->in[0] + (size_t)m * DM : kp->in[1] + (size_t)(m - MP) * DM;
        f32x4 v[4]; float s = 0.f;
#pragma unroll
        for (int j = 0; j < 4; ++j) { v[j] = *(const f32x4*)(xr + 256 * j + 4 * lane); s += v[j][0] * v[j][0] + v[j][1] * v[j][1] + v[j][2] * v[j][2] + v[j][3] * v[j][3]; }
        s = wave_sum(s);
#pragma unroll
        for (int j = 0; j < 4; ++j) { u32x2 w; w.x = pk2(v[j][0], v[j][1]); w.y = pk2(v[j][2], v[j][3]); *(u32x2*)(XB + (size_t)m * DM + 256 * j + 4 * lane) = w; }
        if (lane < 16) xpart[((size_t)(lane >> 2) * MT + m) * 4 + (lane & 3)] = s * (1.f / 16.f);
    }
    const int gt = blockIdx.x * 512 + tid, NGT = G * 512;
    bf16_t* WSB = (bf16_t*)(kp->ws + WS_WSB);
    for (int i = gt; i < 2 * 4 * 128 * 128; i += NGT) { const int s = i & 127, t = (i >> 7) & 127; WSB[i] = (bf16_t)(s <= t ? f2bf(kp->in[6][i]) : 0u); }
    if (blockIdx.x == 0 && wave == 0) {
        for (int li = 0; li < 2; ++li) {
            const float d1 = wave_sum(kp->in[9][li * 64 + lane] * kp->in[10][li * 64 + lane]);
            const float d2 = wave_sum(kp->in[11][li * 64 + lane] * kp->in[12][li * 64 + lane]);
            const float lam_init = 0.8f - 0.6f * expf(-0.3f * (float)li);
            if (lane == 0) ctl[li] = expf(d1) - expf(d2) + lam_init;
        }
    }
}

constexpr int KP = 272, VP = 320, KIMG = 64 * KP, VIMG = 64 * VP;
constexpr int L_K0 = 0, L_V0 = 2 * KIMG, L_WSF = L_V0 + 2 * VIMG, L_ATT_END = L_WSF + 2048;
static_assert(L_ATT_END <= LDS_BYTES && 128 * 128 * 4 <= L_WSF, "attention LDS map");
__device__ __forceinline__ int crow(int i, int h) { return (i & 3) + 8 * (i >> 2) + 4 * h; }
typedef short v4i16_t __attribute__((ext_vector_type(4)));
__device__ __forceinline__ s16x4 trr(const LAS unsigned char* p) { return __builtin_bit_cast(s16x4, __builtin_amdgcn_ds_read_tr16_b64_v4i16((LAS v4i16_t*)p)); }
#define MFMA32(a, b, c) __builtin_amdgcn_mfma_f32_32x32x16_bf16((a), (b), (c), 0, 0, 0)

struct AttnArgs { const bf16_t *QB, *KB, *VB, *BZ; bf16_t* YB; const float *ck, *cv, *nks, *nvs; const float* ang; float lam, post; };

template <bool SAMPLE>
__device__ __forceinline__ void attn_unit(LAS unsigned char* lds, const AttnArgs& A, int b, int h, int qb) {
    constexpr int ND = SAMPLE ? 2 : 4;
    int tid_ = threadIdx.x; asm volatile("" : "+v"(tid_)); const int tid = tid_, lane = tid & 63, w = __builtin_amdgcn_readfirstlane(tid >> 6), r = lane & 31, hh = lane >> 5;
    const int map = w >> 2, wq = SAMPLE ? ((w >> 1) & 1) : (w & 3), dbase = SAMPLE ? (w & 1) * 2 : 0;
    const int NT = SAMPLE ? 33 : 2 * qb + 2;
    const int ntw = SAMPLE ? 33 : 2 * qb + 1 + (wq >> 1);
    const size_t qrow0 = SAMPLE ? (size_t)MP + (size_t)b * DSEQ : (size_t)b * SEQ + (size_t)qb * 128;
    bf16x8 qf[4];
    { const size_t qr = qrow0 + wq * 32 + r; const bf16_t* qp = A.QB + qr * DM + h * 128 + map * 64 + hh * 8;
#pragma unroll
      for (int ds = 0; ds < 4; ++ds) qf[ds] = *(const bf16x8*)(qp + ds * 16); }
    const int lr = tid >> 4, c16 = tid & 15;
    u32x4 kst[2], vst[2];
    f32x4 ksf[2][2], vsf[2][2];
    auto issue = [&](int t) {
        if (!SAMPLE) {
            const size_t base = ((size_t)b * SEQ + (size_t)t * 64 + lr) * DM + h * 128 + c16 * 8;
#pragma unroll
            for (int i = 0; i < 2; ++i) { kst[i] = *(const u32x4*)(A.KB + base + (size_t)i * 32 * DM); vst[i] = *(const u32x4*)(A.VB + base + (size_t)i * 32 * DM); }
        } else {
            const size_t off = (size_t)lr * DM + h * 128 + c16 * 8;
            if (t < 32) {
                const float* kb = A.ck + ((size_t)b * PAST + (size_t)t * 64) * DM;
                const float* vb = A.cv + ((size_t)b * PAST + (size_t)t * 64) * DM;
#pragma unroll
                for (int i = 0; i < 2; ++i) { ksf[i][0] = *(const f32x4*)(kb + off + (size_t)i * 32 * DM); ksf[i][1] = *(const f32x4*)(kb + off + (size_t)i * 32 * DM + 4);
                                              vsf[i][0] = *(const f32x4*)(vb + off + (size_t)i * 32 * DM); vsf[i][1] = *(const f32x4*)(vb + off + (size_t)i * 32 * DM + 4); }
            } else {
                const bf16_t* kb = A.KB + ((size_t)MP + (size_t)b * DSEQ) * DM;
                const bf16_t* vb = A.VB + ((size_t)MP + (size_t)b * DSEQ) * DM;
#pragma unroll
                for (int i = 0; i < 2; ++i) {
                    const u32x4 kr = *(const u32x4*)(kb + off + (size_t)i * 32 * DM), vr = *(const u32x4*)(vb + off + (size_t)i * 32 * DM);
                    ksf[i][0] = (f32x4){bf2f(kr.x & 0xffffu), bf2f(kr.x >> 16), bf2f(kr.y & 0xffffu), bf2f(kr.y >> 16)}; ksf[i][1] = (f32x4){bf2f(kr.z & 0xffffu), bf2f(kr.z >> 16), bf2f(kr.w & 0xffffu), bf2f(kr.w >> 16)};
                    vsf[i][0] = (f32x4){bf2f(vr.x & 0xffffu), bf2f(vr.x >> 16), bf2f(vr.y & 0xffffu), bf2f(vr.y >> 16)}; vsf[i][1] = (f32x4){bf2f(vr.z & 0xffffu), bf2f(vr.z >> 16), bf2f(vr.w & 0xffffu), bf2f(vr.w >> 16)};
                }
            }
        }
    };
    auto commit = [&](int buf) {
#pragma unroll
        for (int i = 0; i < 2; ++i) {
            u32x4 kw, vw;
            if (!SAMPLE) { kw = kst[i]; vw = vst[i]; }
            else { kw.x = pk2(ksf[i][0][0], ksf[i][0][1]); kw.y = pk2(ksf[i][0][2], ksf[i][0][3]); kw.z = pk2(ksf[i][1][0], ksf[i][1][1]); kw.w = pk2(ksf[i][1][2], ksf[i][1][3]);
                   vw.x = pk2(vsf[i][0][0], vsf[i][0][1]); vw.y = pk2(vsf[i][0][2], vsf[i][0][3]); vw.z = pk2(vsf[i][1][0], vsf[i][1][1]); vw.w = pk2(vsf[i][1][2], vsf[i][1][3]); }
            *(LAS u32x4*)(lds + L_K0 + buf * KIMG + (lr + 32 * i) * KP + c16 * 16) = kw;
            *(LAS u32x4*)(lds + L_V0 + buf * VIMG + (lr + 32 * i) * VP + c16 * 16) = vw;
        }
    };
    LAS float* wsf = (LAS float*)(lds + L_WSF) + w * 64;
    f32x16 o[ND];
#pragma unroll
    for (int d = 0; d < ND; ++d)
#pragma unroll
        for (int i = 0; i < 16; ++i) o[d][i] = 0.f;
    float mrun = 0.f, lrun = 0.f;
    f32x16 negm;
#pragma unroll
    for (int i = 0; i < 16; ++i) negm[i] = 0.f;
    const int q4 = (lane & 15) >> 2, pp = lane & 3, blk = (lane >> 4) & 1;
    const int koff = map * 128 + r * KP + hh * 16, voff = (4 * hh + q4) * VP + blk * 32 + pp * 8 + dbase * 64;

    issue(0); commit(0); __syncthreads();
    for (int t = 0; t < NT; ++t) {
        const int buf = t & 1;
        if (t + 1 < NT) issue(t + 1);
        if (t < ntw) {
            const LAS unsigned char* kb = lds + L_K0 + buf * KIMG + koff;
            f32x16 p0, p1;
#pragma unroll
            for (int ds = 0; ds < 4; ++ds) {
                const bf16x8 k0 = *(const LAS bf16x8*)(kb + ds * 32), k1 = *(const LAS bf16x8*)(kb + 32 * KP + ds * 32);
                if (ds == 0) { p0 = MFMA32(k0, qf[0], negm); p1 = MFMA32(k1, qf[0], negm); }
                else { p0 = MFMA32(k0, qf[ds], p0); p1 = MFMA32(k1, qf[ds], p1); }
            }
            float mx = fmaxf(p0[0], p1[0]);
#pragma unroll
            for (int i = 1; i < 16; ++i) mx = fmaxf(mx, fmaxf(p0[i], p1[i]));
            mx = fmaxf(mx, __shfl_xor(mx, 32));
            const bool first = (t == 0);
            if (first || __any(mx > 8.f)) {
                const float dl = first ? mx : fmaxf(mx, 0.f);
                const float al = first ? 1.f : fexp2(-dl);
                lrun *= al; mrun += dl;
#pragma unroll
                for (int i = 0; i < 16; ++i) { p0[i] -= dl; p1[i] -= dl; negm[i] = -mrun; }
                if (!first) {
                    if (hh == 0) wsf[r] = al;
                    asm volatile("s_waitcnt lgkmcnt(0)" ::: "memory");
#pragma unroll
                    for (int g = 0; g < 4; ++g) { const f32x4 a4 = *(const LAS f32x4*)(wsf + 8 * g + 4 * hh);
#pragma unroll
                        for (int d = 0; d < ND; ++d)
#pragma unroll
                            for (int j = 0; j < 4; ++j) o[d][4 * g + j] *= a4[j]; }
                }
            }
            float ls = 0.f;
#pragma unroll
            for (int i = 0; i < 16; ++i) { p0[i] = fexp2(p0[i]); p1[i] = fexp2(p1[i]); ls += p0[i] + p1[i]; }
            lrun += ls;
            bf16x8 pa[4];
#pragma unroll
            for (int s = 0; s < 4; ++s) {
                u32x4 pw;
                if (s < 2) { pw.x = pk2(p0[8 * s + 0], p0[8 * s + 1]); pw.y = pk2(p0[8 * s + 2], p0[8 * s + 3]); pw.z = pk2(p0[8 * s + 4], p0[8 * s + 5]); pw.w = pk2(p0[8 * s + 6], p0[8 * s + 7]); }
                else { const int s2 = s - 2; pw.x = pk2(p1[8 * s2 + 0], p1[8 * s2 + 1]); pw.y = pk2(p1[8 * s2 + 2], p1[8 * s2 + 3]); pw.z = pk2(p1[8 * s2 + 4], p1[8 * s2 + 5]); pw.w = pk2(p1[8 * s2 + 6], p1[8 * s2 + 7]); }
                pa[s] = __builtin_bit_cast(bf16x8, pw);
            }
            const LAS unsigned char* vb = lds + L_V0 + buf * VIMG + voff;
#pragma unroll
            for (int d = 0; d < ND; ++d) {
#pragma unroll
                for (int s = 0; s < 4; ++s) {
                    const s16x4 lo = trr(vb + s * 16 * VP + d * 64), hi = trr(vb + s * 16 * VP + 8 * VP + d * 64);
                    const bf16x8 vf = __builtin_shufflevector(lo, hi, 0, 1, 2, 3, 4, 5, 6, 7);
                    o[d] = MFMA32(pa[s], vf, o[d]);
                }
                if (d & 1) __builtin_amdgcn_sched_barrier(0);
            }
        }
        if (t + 1 < NT) commit(buf ^ 1);
        __syncthreads();
    }
    {
        lrun += __shfl_xor(lrun, 32);
        if (hh == 0) wsf[r] = frcp(lrun);
        asm volatile("s_waitcnt lgkmcnt(0)" ::: "memory");
#pragma unroll
        for (int g = 0; g < 4; ++g) { const f32x4 a4 = *(const LAS f32x4*)(wsf + 8 * g + 4 * hh);
#pragma unroll
            for (int d = 0; d < ND; ++d)
#pragma unroll
                for (int j = 0; j < 4; ++j) o[d][4 * g + j] *= a4[j]; }
    }
    LAS float* exch = (LAS float*)lds;
    LAS float* red = (LAS float*)(lds + 65536);
    if (map == 1) {
#pragma unroll
        for (int d = 0; d < ND; ++d)
#pragma unroll
            for (int i = 0; i < 16; ++i) exch[(wq * 32 + crow(i, hh)) * 128 + (dbase + d) * 32 + r] = o[d][i];
    }
    __syncthreads();
    float ss[16];
#pragma unroll
    for (int i = 0; i < 16; ++i) ss[i] = 0.f;
    if (map == 0) {
#pragma unroll
        for (int d = 0; d < ND; ++d)
#pragma unroll
            for (int i = 0; i < 16; ++i) { const float v = o[d][i] - A.lam * exch[(wq * 32 + crow(i, hh)) * 128 + (dbase + d) * 32 + r]; o[d][i] = v; ss[i] += v * v; }
#pragma unroll
        for (int i = 0; i < 16; ++i) {
#pragma unroll
            for (int off = 1; off < 32; off <<= 1) ss[i] += __shfl_xor(ss[i], off);
        }
        if (SAMPLE && r == 0) {
#pragma unroll
            for (int i = 0; i < 16; ++i) red[w * 32 + crow(i, hh)] = ss[i];
        }
    }
    if (SAMPLE) __syncthreads();
    if (map == 0) {
#pragma unroll
        for (int i = 0; i < 16; ++i) {
            if (SAMPLE) ss[i] += red[(w ^ 1) * 32 + crow(i, hh)];
            ss[i] = __builtin_amdgcn_rsqf(ss[i] * (1.f / 128.f) + EPS) * A.post;
        }
#pragma unroll
        for (int d = 0; d < ND; ++d) {
            const float gc = A.ang[(dbase + d) * 32 + r];
#pragma unroll
            for (int i = 0; i < 16; ++i) {
                const size_t idx = (qrow0 + wq * 32 + crow(i, hh)) * DM + h * 128 + (dbase + d) * 32 + r;
                A.YB[idx] = (bf16_t)f2bf(o[d][i] * ss[i] * gc * bf2f(A.BZ[idx]));
            }
        }
    }
    __syncthreads();
}

constexpr int XP = 576, L_RINV = 128 * XP;
__device__ __forceinline__ void spatial_unit(LAS unsigned char* lds, int row0, int nrows, int g, const bf16_t* AV, const bf16_t* UZ, bf16_t* YA,
                                             const float* avssq, const bf16_t* WsB, const float* bsg, const float* vng, float* mlpv) {
    int tid_ = threadIdx.x; asm volatile("" : "+v"(tid_)); const int tid = tid_, lane = tid & 63, w = __builtin_amdgcn_readfirstlane(tid >> 6), r = lane & 31, hh = lane >> 5;
    LAS float* rinv = (LAS float*)(lds + L_RINV);
    if (tid < nrows) { const float* q = avssq + (size_t)(row0 + tid) * 4; const f32x4 a = *(const f32x4*)q, b4 = *(const f32x4*)(q + (size_t)MT * 4), c4 = *(const f32x4*)(q + (size_t)MT * 8), d4 = *(const f32x4*)(q + (size_t)MT * 12);
        const float s = ((a[0] + a[1]) + (a[2] + a[3])) + ((b4[0] + b4[1]) + (b4[2] + b4[3])) + ((c4[0] + c4[1]) + (c4[2] + c4[3])) + ((d4[0] + d4[1]) + (d4[2] + d4[3]));
        rinv[tid] = __builtin_amdgcn_rsqf(s * (1.f / 1024.f) + EPS); }
    __syncthreads();
    for (int i = 0; i < nrows / 16; ++i) {
        const int c = tid + 512 * i, s = c >> 5, c8 = c & 31;
        const u32x4 raw = *(const u32x4*)(AV + (size_t)(row0 + s) * DM + g * 256 + c8 * 8);
        const float ri = rinv[s];
        const f32x4 g0 = *(const f32x4*)(vng + g * 256 + c8 * 8), g1 = *(const f32x4*)(vng + g * 256 + c8 * 8 + 4);
        f32x4 x0, x1;
        x0[0] = bf2f(raw.x & 0xffffu) * ri * g0[0]; x0[1] = bf2f(raw.x >> 16) * ri * g0[1]; x0[2] = bf2f(raw.y & 0xffffu) * ri * g0[2]; x0[3] = bf2f(raw.y >> 16) * ri * g0[3];
        x1[0] = bf2f(raw.z & 0xffffu) * ri * g1[0]; x1[1] = bf2f(raw.z >> 16) * ri * g1[1]; x1[2] = bf2f(raw.w & 0xffffu) * ri * g1[2]; x1[3] = bf2f(raw.w >> 16) * ri * g1[3];
        if (mlpv) { *(f32x4*)(mlpv + (size_t)s * DM + g * 256 + c8 * 8) = x0; *(f32x4*)(mlpv + (size_t)s * DM + g * 256 + c8 * 8 + 4) = x1; }
        u32x4 pw; pw.x = pk2(x0[0], x0[1]); pw.y = pk2(x0[2], x0[3]); pw.z = pk2(x1[0], x1[1]); pw.w = pk2(x1[2], x1[3]);
        *(LAS u32x4*)(lds + s * XP + c8 * 16) = pw;
    }
    __syncthreads();
    const int tb = w & 3, chalf = w >> 2;
    if (tb * 32 < nrows) {
        f32x16 acc[4];
#pragma unroll
        for (int cb = 0; cb < 4; ++cb)
#pragma unroll
            for (int i = 0; i < 16; ++i) acc[cb][i] = 0.f;
        const int q4 = (lane & 15) >> 2, pp = lane & 3, blk = (lane >> 4) & 1;
        const bf16_t* wrow = WsB + (size_t)(32 * tb + r) * 128 + 8 * hh;
        const LAS unsigned char* xb = lds + (8 * hh + q4) * XP + (chalf * 128 + blk * 16) * 2 + pp * 8;
        const int nks = 2 * (tb + 1);
        for (int ks = 0; ks < nks; ++ks) {
            const bf16x8 wb = *(const bf16x8*)(wrow + 16 * ks);
#pragma unroll
            for (int cb = 0; cb < 4; ++cb) {
                const s16x4 lo = trr(xb + ks * 16 * XP + cb * 64), hi = trr(xb + ks * 16 * XP + 4 * XP + cb * 64);
                const bf16x8 xa = __builtin_shufflevector(lo, hi, 0, 1, 2, 3, 4, 5, 6, 7);
                acc[cb] = MFMA32(xa, wb, acc[cb]);
            }
        }
        const int t = 32 * tb + r; const float bs = bsg[t]; const size_t ro = (size_t)(row0 + t) * DM + g * 256 + chalf * 128;
#pragma unroll
        for (int cb = 0; cb < 4; ++cb)
#pragma unroll
            for (int gq = 0; gq < 4; ++gq) {
                const size_t idx = ro + cb * 32 + 8 * gq + 4 * hh;
                const u32x2 uz = *(const u32x2*)(UZ + idx);
                u32x2 ow;
                ow.x = pk2((acc[cb][4 * gq + 0] + bs) * bf2f(uz.x & 0xffffu), (acc[cb][4 * gq + 1] + bs) * bf2f(uz.x >> 16));
                ow.y = pk2((acc[cb][4 * gq + 2] + bs) * bf2f(uz.y & 0xffffu), (acc[cb][4 * gq + 3] + bs) * bf2f(uz.y >> 16));
                *(u32x2*)(YA + idx) = ow;
            }
    }
    __syncthreads();
}
#ifndef ATT_REPS
#define ATT_REPS 1
#endif
#ifndef LIGHT_REPS
#define LIGHT_REPS 1
#endif
#ifndef P1_REPS
#define P1_REPS 1
#endif
#ifndef CONVERT_IN_LOOP
#define CONVERT_IN_LOOP 0
#endif
#ifndef CONVERT_AT_END
#define CONVERT_AT_END 0
#endif
#ifndef SKIP_P0
#define SKIP_P0 0
#endif
#ifndef SKIP_P1
#define SKIP_P1 0
#endif
#ifndef SKIP_P2
#define SKIP_P2 0
#endif
#ifndef SKIP_P3A
#define SKIP_P3A 0
#endif
#ifndef SKIP_P3B
#define SKIP_P3B 0
#endif
typedef const __attribute__((address_space(4))) Params* KArgs;
__device__ __forceinline__ KArgs kargs() { KArgs k = (KArgs)__builtin_amdgcn_kernarg_segment_ptr(); asm volatile("" : "+s"(k)); return k; }
#define KP_DECL() KArgs kp = kargs(); float* ctl = (float*)(kp->ws + WS_CTL); bf16_t* act = (bf16_t*)(kp->ws + WS_ACT); bf16_t* XB = (bf16_t*)(kp->ws + WS_XB); float* X1 = (float*)(kp->ws + WS_X1); (void)ctl; (void)act; (void)XB; (void)X1
__global__ void __launch_bounds__(512, 2) fwd_kernel(Params p) {
    extern __shared__ __attribute__((aligned(16))) unsigned char lds_raw[];
    LAS unsigned char* lds = (LAS unsigned char*)lds_raw;
    cg::grid_group grid = cg::this_grid();
    const int G = gridDim.x, bx = blockIdx.x;
    const int vcu = (G % 8 == 0) ? (bx % 8) * (G / 8) + bx / 8 : bx;
    int ph = 0;
#define PH_IN() (p.ph_lo <= ph && ph < p.ph_hi)
#define PH_END() do { if (p.ph_lo <= ph && ph + 1 < p.ph_hi) { __builtin_amdgcn_fence(__ATOMIC_RELEASE, "agent"); asm volatile("s_waitcnt vmcnt(0) lgkmcnt(0)" ::: "memory"); \
        grid.sync(); __builtin_amdgcn_fence(__ATOMIC_ACQUIRE, "agent"); asm volatile("s_waitcnt vmcnt(0) lgkmcnt(0)" ::: "memory"); } ++ph; } while (0)
    if (PH_IN() && !SKIP_P0) { KArgs kp = kargs(); phase_prologue(kp, lds); }
    PH_END();
#pragma unroll 1
    for (int li = 0; li < 2; ++li) {
        if (PH_IN() && !SKIP_P1) {
            KP_DECL(); float* xssq_cur = (float*)(kp->ws + WS_PART) + (size_t)li * MT * 16; float* avssq = (float*)(kp->ws + WS_PART) + (size_t)(2 + li) * MT * 16;
            pg8::Gemm g{li == 0 ? XB : (const bf16_t*)(kp->ws + WS_XB1), (const bf16_t*)(kp->ws + WS_WIN) + (size_t)li * DIN * DM, MT, DIN, DM};
            pg8::StaticOrder S; S.init(MT, DIN, G, bx);
            pg8::EpiIn E{xssq_cur, avssq, act, kp->out + O_KP + (size_t)li * MP * DM, kp->out + O_VP + (size_t)li * MP * DM, kp->out + O_KS + (size_t)li * MS * DM, kp->out + O_VS + (size_t)li * MS * DM};
            for (int rep = 0; rep < P1_REPS; ++rep) pg8::gemm_phase<pg8::EpiIn, pg8::StaticOrder, true, true>(lds, g, S, E);
        }
        PH_END();
        if (PH_IN() && !SKIP_P2) {
            KP_DECL(); float* avssq = (float*)(kp->ws + WS_PART) + (size_t)(2 + li) * MT * 16;
            AttnArgs A;
            A.QB = act + A_QB * ACT; A.KB = act + A_KB * ACT; A.VB = act + A_VB * ACT; A.BZ = act + A_BZ * ACT; A.YB = act + A_YB * ACT;
            A.ck = kp->in[2] + (size_t)li * DBATCH * PAST * DM; A.cv = kp->in[3] + (size_t)li * DBATCH * PAST * DM;
            A.nks = kp->out + O_KS + (size_t)li * MS * DM; A.nvs = kp->out + O_VS + (size_t)li * MS * DM;
            A.ang = kp->in[13] + li * 128; A.lam = ctl[li]; A.post = 1.f - (0.8f - 0.6f * expf(-0.3f * (float)li));
            if (CONVERT_IN_LOOP) {
                const unsigned* kb = (const unsigned*)(act + A_KB * ACT); const unsigned* vb = (const unsigned*)(act + A_VB * ACT);
                float* ko = kp->out + O_KP + (size_t)li * MP * DM; float* vo = kp->out + O_VP + (size_t)li * MP * DM;
                float* kso = kp->out + O_KS + (size_t)li * MS * DM; float* vso = kp->out + O_VS + (size_t)li * MS * DM;
                int ct_ = threadIdx.x, cb_ = blockIdx.x, cg_ = gridDim.x; asm volatile("" : "+v"(ct_), "+s"(cb_), "+s"(cg_));
                for (size_t i = (size_t)cb_ * 512 + ct_; i < (size_t)MT * DM / 8; i += (size_t)cg_ * 512) {
                    const u32x4 a = *(const u32x4*)(kb + 4 * i), c4 = *(const u32x4*)(vb + 4 * i);
                    const size_t e = 8 * i;
                    float* kd = e < (size_t)MP * DM ? ko + e : kso + (e - (size_t)MP * DM);
                    float* vd = e < (size_t)MP * DM ? vo + e : vso + (e - (size_t)MP * DM);
                    *(f32x4*)kd = (f32x4){bf2f(a.x & 0xffffu), bf2f(a.x >> 16), bf2f(a.y & 0xffffu), bf2f(a.y >> 16)}; *(f32x4*)(kd + 4) = (f32x4){bf2f(a.z & 0xffffu), bf2f(a.z >> 16), bf2f(a.w & 0xffffu), bf2f(a.w >> 16)};
#ifdef CONVERT_K_ONLY
                    if (li == 0)
#endif
                    { *(f32x4*)vd = (f32x4){bf2f(c4.x & 0xffffu), bf2f(c4.x >> 16), bf2f(c4.y & 0xffffu), bf2f(c4.y >> 16)}; *(f32x4*)(vd + 4) = (f32x4){bf2f(c4.z & 0xffffu), bf2f(c4.z >> 16), bf2f(c4.w & 0xffffu), bf2f(c4.w >> 16)}; }
                }
            }
#ifdef P2L1_CONVERT_ONLY
            if (li == 0) {
#else
            {
#endif
            const int per = (1024 + G - 1) / G;
            for (int rep = 0; rep < ATT_REPS; ++rep)
            for (int it = vcu * per; it < (vcu + 1) * per && it < 1024; ++it) {
                const int bh = it >> 4, j = it & 15;
#ifndef SKIP_PA
                attn_unit<false>(lds, A, bh >> 3, bh & 7, j);
                attn_unit<false>(lds, A, bh >> 3, bh & 7, 31 - j);
#endif
            }
            const bool split = (G >= 256);
            for (int lrep = 0; lrep < LIGHT_REPS; ++lrep)
            for (int it = split ? (vcu < 128 ? vcu : 128 + (vcu - 128)) : vcu; it < 128 + 1024 + 64; it += split ? (vcu < 128 ? 1 << 30 : (G - 128)) : G) {
                if (it < 128) {
#ifndef SKIP_SA
                    attn_unit<true>(lds, A, it >> 3, it & 7, 0);
#endif
                }
                else if (it < 1152) { const int sp = it - 128, ch = sp >> 2, g = sp & 3;
                    spatial_unit(lds, ch * 128, 128, g, act + A_AV * ACT, act + A_UZ * ACT, act + A_YA * ACT, avssq, (const bf16_t*)(kp->ws + WS_WSB) + (size_t)(li * 4 + g) * 128 * 128,
                                 kp->in[7] + (li * 4 + g) * 128, kp->in[8] + li * DM, nullptr); }
                else { const int sp = it - 1152, b = sp >> 2, g = sp & 3;
                    spatial_unit(lds, MP + b * DSEQ, 64, g, act + A_AV * ACT, act + A_UZ * ACT, act + A_YA * ACT, avssq, (const bf16_t*)(kp->ws + WS_WSB) + (size_t)(li * 4 + g) * 128 * 128,
                                 kp->in[7] + (li * 4 + g) * 128, kp->in[8] + li * DM, kp->out + O_MV + ((size_t)li * MS + (size_t)b * DSEQ) * DM); }
            }
            }
        }
        PH_END();
        if (PH_IN() && !SKIP_P3A) {
            KP_DECL();
            pg8::StaticOrder S; S.init(MT, DM, G, bx);
            { pg8::Gemm g{act + A_YA * ACT, (const bf16_t*)(kp->ws + WS_WPA) + (size_t)li * DM * DM, MT, DM, DM};
#ifdef SKIP_G2
              pg8::EpiGate<0> E{act + A_SGA * ACT, nullptr, act + A_AV * ACT};
#else
              pg8::EpiGate<0> E{act + A_SGA * ACT, nullptr, act + A_UZ * ACT};
#endif
              pg8::gemm_phase<pg8::EpiGate<0>, pg8::StaticOrder, true, true>(lds, g, S, E); }
#ifndef SKIP_G2
            { pg8::Gemm g{act + A_YB * ACT, (const bf16_t*)(kp->ws + WS_WPB) + (size_t)li * DM * DM, MT, DM, DM};
              pg8::EpiGate<1> E{act + A_SGB * ACT, act + A_UZ * ACT, act + A_AV * ACT};
              pg8::gemm_phase<pg8::EpiGate<1>, pg8::StaticOrder, true, true>(lds, g, S, E); }
#endif
        }
        PH_END();
        if (PH_IN() && !SKIP_P3B) {
            KP_DECL();
            pg8::StaticOrder S; S.init(MT, DM, G, bx);
            pg8::Gemm g{act + A_AV * ACT, (const bf16_t*)(kp->ws + WS_WOUT) + (size_t)li * DM * DM, MT, DM, DM};
            pg8::EpiRes E{li == 0 ? kp->in[0] : X1, li == 0 ? kp->in[1] : X1 + (size_t)MP * DM, X1, (bf16_t*)(kp->ws + WS_XB1), (float*)(kp->ws + WS_PART) + (size_t)MT * 16, li == 0 ? 1 : 0};
            pg8::gemm_phase<pg8::EpiRes, pg8::StaticOrder, true, true>(lds, g, S, E);
        }
        PH_END();
    }
#ifdef DUMP_OFF
    {
        __builtin_amdgcn_fence(__ATOMIC_RELEASE, "agent"); asm volatile("s_waitcnt vmcnt(0) lgkmcnt(0)" ::: "memory"); grid.sync(); __builtin_amdgcn_fence(__ATOMIC_ACQUIRE, "agent"); asm volatile("s_waitcnt vmcnt(0) lgkmcnt(0)" ::: "memory");
        KP_DECL();
        const unsigned* srcb = (const unsigned*)(kp->ws + (size_t)(DUMP_OFF));
#ifdef DUMP_WIDE
        {
            float* ko = kp->out + O_KP + (size_t)MP * DM; float* kso = kp->out + O_KS + (size_t)MS * DM;
            for (size_t i = (size_t)bx * 512 + threadIdx.x; i < (size_t)MT * DM / 8; i += (size_t)G * 512) {
                const u32x4 a = *(const u32x4*)(srcb + 4 * i);
                const size_t e = 8 * i;
                float* kd = e < (size_t)MP * DM ? ko + e : kso + (e - (size_t)MP * DM);
                *(f32x4*)kd = (f32x4){bf2f(a.x & 0xffffu), bf2f(a.x >> 16), bf2f(a.y & 0xffffu), bf2f(a.y >> 16)}; *(f32x4*)(kd + 4) = (f32x4){bf2f(a.z & 0xffffu), bf2f(a.z >> 16), bf2f(a.w & 0xffffu), bf2f(a.w >> 16)};
            }
        }
#else
        for (size_t i = (size_t)bx * 512 + threadIdx.x; i < (size_t)MT * DM / 2; i += (size_t)G * 512) {
#ifdef DUMP_F32
            if (i < (size_t)DUMP_F32) kp->out[O_YP + i] = ((const float*)srcb)[i];
#else
            const unsigned v = srcb[i];
            if (i < (size_t)MP * DM / 2) { kp->out[O_KP + (size_t)MP * DM + 2 * i] = bf2f(v & 0xffffu); kp->out[O_KP + (size_t)MP * DM + 2 * i + 1] = bf2f(v >> 16); }
            else { const size_t j = i - (size_t)MP * DM / 2; kp->out[O_KS + (size_t)MS * DM + 2 * j] = bf2f(v & 0xffffu); kp->out[O_KS + (size_t)MS * DM + 2 * j + 1] = bf2f(v >> 16); }
#endif
        }
#endif
    }
#endif
    if (PH_IN()) {
        KP_DECL();
        if (CONVERT_AT_END) {
            const unsigned* kb = (const unsigned*)(act + A_KB * ACT); const unsigned* vb = (const unsigned*)(act + A_VB * ACT);
            float* ko = kp->out + O_KP + (size_t)MP * DM; float* vo = kp->out + O_VP + (size_t)MP * DM;
            float* kso = kp->out + O_KS + (size_t)MS * DM; float* vso = kp->out + O_VS + (size_t)MS * DM;
            for (size_t i = (size_t)bx * 512 + threadIdx.x; i < (size_t)MT * DM / 8; i += (size_t)G * 512) {
                const u32x4 a = *(const u32x4*)(kb + 4 * i), c4 = *(const u32x4*)(vb + 4 * i);
                const size_t e = 8 * i;
                float* kd = e < (size_t)MP * DM ? ko + e : kso + (e - (size_t)MP * DM);
                float* vd = e < (size_t)MP * DM ? vo + e : vso + (e - (size_t)MP * DM);
                *(f32x4*)kd = (f32x4){bf2f(a.x & 0xffffu), bf2f(a.x >> 16), bf2f(a.y & 0xffffu), bf2f(a.y >> 16)}; *(f32x4*)(kd + 4) = (f32x4){bf2f(a.z & 0xffffu), bf2f(a.z >> 16), bf2f(a.w & 0xffffu), bf2f(a.w >> 16)};
                *(f32x4*)vd = (f32x4){bf2f(c4.x & 0xffffu), bf2f(c4.x >> 16), bf2f(c4.y & 0xffffu), bf2f(c4.y >> 16)}; *(f32x4*)(vd + 4) = (f32x4){bf2f(c4.z & 0xffffu), bf2f(c4.z >> 16), bf2f(c4.w & 0xffffu), bf2f(c4.w >> 16)};
            }
        }
        int tid_ = threadIdx.x; asm volatile("" : "+v"(tid_)); const int lane = tid_ & 63, wave = tid_ >> 6;
        const int gw = bx * 8 + wave, NGW = G * 8;
        const float* gf = kp->in[17];
        f32x4 gv[4];
#pragma unroll
        for (int j = 0; j < 4; ++j) gv[j] = *(const f32x4*)(gf + 256 * j + 4 * lane);
        for (int m = gw; m < MT; m += NGW) {
            const float* xr = X1 + (size_t)m * DM;
            f32x4 v[4]; float s = 0.f;
#pragma unroll
            for (int j = 0; j < 4; ++j) { v[j] = *(const f32x4*)(xr + 256 * j + 4 * lane); s += v[j][0] * v[j][0] + v[j][1] * v[j][1] + v[j][2] * v[j][2] + v[j][3] * v[j][3]; }
            s = wave_sum(s);
            const float ri = 1.0f / sqrtf(s * (1.f / 1024.f) + EPS);
            float* orow = m < MP ? kp->out + O_YP + (size_t)m * DM : kp->out + O_YS + (size_t)(m - MP) * DM;
#pragma unroll
            for (int j = 0; j < 4; ++j) *(f32x4*)(orow + 256 * j + 4 * lane) = v[j] * ri * gv[j];
        }
    }
}

#ifndef PH_HI
#define PH_HI 100
#endif
#ifndef N_LAUNCH_MODE
#define N_LAUNCH_MODE 1
#endif
extern "C" void kernel_launch(void* const* d_in, const int* in_sizes, int n_in, void* d_out, int out_size, void* d_ws, size_t ws_size, hipStream_t stream) {
    static int grid = 0;
    if (grid == 0) {
        if (n_in != 18 || ws_size < WS_END) { fprintf(stderr, "kernel_launch: unexpected n_in %d / ws %zu (need %zu)\n", n_in, ws_size, (size_t)WS_END); grid = -1; return; }
        int dev = 0, cus = 0, per_cu = 0;
        hipGetDevice(&dev); hipDeviceGetAttribute(&cus, hipDeviceAttributeMultiprocessorCount, dev);
        if (hipFuncSetAttribute((const void*)fwd_kernel, hipFuncAttributeMaxDynamicSharedMemorySize, LDS_BYTES) != hipSuccess) { fprintf(stderr, "kernel_launch: hipFuncSetAttribute failed\n"); grid = -1; return; }
        if (hipOccupancyMaxActiveBlocksPerMultiprocessor(&per_cu, (const void*)fwd_kernel, 512, LDS_BYTES) != hipSuccess || per_cu < 1) { fprintf(stderr, "kernel_launch: occupancy query says %d\n", per_cu); per_cu = 1; }
        (void)hipGetLastError();
        grid = cus * 1;
    }
    if (grid < 0) return;
    Params p{};
    for (int i = 0; i < 18; ++i) p.in[i] = (const float*)d_in[i];
    p.out = (float*)d_out; p.ws = (unsigned char*)d_ws;
#if N_LAUNCH_MODE == 1
    p.ph_lo = 0; p.ph_hi = PH_HI;
    void* args[] = {&p};
    hipError_t e = hipLaunchCooperativeKernel((const void*)fwd_kernel, dim3(grid), dim3(512), args, LDS_BYTES, stream);
    if (e != hipSuccess) fprintf(stderr, "cooperative launch failed: %s (grid %d)\n", hipGetErrorString(e), grid);
#else
    for (int ph = 0; ph < 10 && ph < PH_HI; ++ph) { p.ph_lo = ph; p.ph_hi = ph + 1; hipLaunchKernelGGL(fwd_kernel, dim3(grid), dim3(512), LDS_BYTES, stream, p); }
#endif
}
```

```cpp
#include <hip/hip_runtime.h>
#include <hip/hip_cooperative_groups.h>
#include <cstdio>
#include <cstdint>
namespace cg = cooperative_groups;
namespace pg8 {
#define PG8_LAS __attribute__((address_space(3)))
typedef unsigned short bf16_t;
typedef short bf16x8 __attribute__((ext_vector_type(8)));
typedef float f32x4 __attribute__((ext_vector_type(4)));
typedef unsigned u32x4 __attribute__((ext_vector_type(4)));
constexpr int BM = 256, BK = 64, HALF = 128, HTB = HALF * BK * 2  , STAGE_BYTES = 8 * HTB, NXCD = 8, WGM = 8;

__host__ __device__ __forceinline__ int lds_byte(int r, int c) { const int st = (r >> 4) * 2 + (c >> 5), rr = r & 15, cc = c & 31, ob = rr * 64 + cc * 2; return st * 1024 + (ob ^ (((ob >> 9) & 1) << 5)); }
__host__ __device__ __forceinline__ void stage_rc(int b, int& R, int& C) { const int st = b / 1024, sb = b % 1024, swz = sb ^ (((sb >> 9) & 1) << 5); R = (st >> 1) * 16 + swz / 64; C = (st & 1) * 32 + (swz % 64) / 2; }
__host__ __device__ __forceinline__ int perm32(int rho) { const int n = rho >> 4, i = rho & 15; return 8 * (i >> 2) + 4 * n + (i & 3); }

struct Unit { int pm, pn; };
struct Gemm { const bf16_t* A; const bf16_t* Bt; int M, N, K; };

struct StaticOrder {
    int nM, nN, nwg, G, c;
    __host__ __device__ void init(int M, int N, int G_, int c_) { nM = M / BM; nN = N / BM; nwg = nM * nN; G = G_; c = c_; }
    __host__ __device__ bool next(int i, Unit& u) const {
        const long L = (long)i * G + c; if (L >= nwg) return false;
        int wgid = (int)L; { const int q = nwg / NXCD, r = nwg % NXCD, xcd = wgid % NXCD, off = wgid / NXCD; wgid = (xcd < r ? xcd * (q + 1) : r * (q + 1) + (xcd - r) * q) + off; }
        const int nig = WGM * nN, gid = wgid / nig, fm = gid * WGM, gsz = (nM - fm) < WGM ? (nM - fm) : WGM;
        u.pm = fm + ((wgid % nig) % gsz); u.pn = (wgid % nig) / gsz; return true;
    }
    __device__ __forceinline__ void a_ready(const Unit&) const {}
    __device__ __forceinline__ void done(const Unit&) const {}
};

typedef float f32x2 __attribute__((ext_vector_type(2)));
typedef float f32x2cv __attribute__((ext_vector_type(2))); typedef __bf16 bf16x2cv __attribute__((ext_vector_type(2)));
__device__ __forceinline__ unsigned cvt_pk_bf16(float lo, float hi) { const f32x2cv v = {lo, hi}; const bf16x2cv b = __builtin_convertvector(v, bf16x2cv); return __builtin_bit_cast(unsigned, b); }

#ifndef EPI_DRAIN_N
#define EPI_DRAIN_N 8
#endif
#define PG8_STR2(x) #x
#define PG8_STR(x) PG8_STR2(x)
#define EPI_DRAIN() asm volatile("s_waitcnt vmcnt(0)" ::: "memory")
template <class Epi, class Sched, bool ALIGN_EPI = false, bool SP2 = false>
__device__ __forceinline__ void gemm_phase(PG8_LAS unsigned char* lds, const Gemm g, const Sched& S, const Epi& E) {
    int tid_ = threadIdx.x; asm volatile("" : "+v"(tid_)); const int tid = tid_, wid = __builtin_amdgcn_readfirstlane(tid >> 6), lane = tid & 63, wr = wid >> 2, wc = wid & 3, fr = lane & 15, fq = lane >> 4;
    const int K = g.K, nt = K / BK;
    unsigned voffA[2], voffB[2];
#pragma unroll
    for (int i = 0; i < 2; ++i) { int R, C; stage_rc(tid * 16 + i * 8192, R, C); const int Rb = Epi::PERM ? ((R & ~31) + perm32(R & 31)) : R;
        voffA[i] = (unsigned)(R * K + C) * 2u; voffB[i] = (unsigned)(Rb * K + C) * 2u; }
    const size_t kstep = (size_t)(BK * 2);
    const size_t hstep = (size_t)HALF * K * 2;
    const size_t tstep = 2 * hstep;
    const unsigned ldsw = (unsigned)wid * 1024u;
    const int aoff = lds_byte(wr * 64 + fr, fq * 8), boff = lds_byte(wc * 32 + fr, fq * 8);
#define PG8_SA(b, h) (((b) * 2 + (h)) * HTB)
#define PG8_SB(b, h) ((4 + (b) * 2 + (h)) * HTB)
#define PG8_STAGE(bufoff, gbase, voff) do { _Pragma("unroll") for (int _i = 0; _i < 2; ++_i) \
        __builtin_amdgcn_global_load_lds((const unsigned*)((const char*)(gbase) + (voff)[_i]), (PG8_LAS unsigned*)(lds + (bufoff) + ldsw + _i * 8192), 16, 0, 0); } while (0)
#define PG8_LDA(dst, b, h) do { _Pragma("unroll") for (int m = 0; m < 4; ++m) _Pragma("unroll") for (int k = 0; k < 2; ++k) dst[m][k] = *(const PG8_LAS bf16x8*)(lds + PG8_SA(b, h) + aoff + m * 2048 + k * 1024); } while (0)
#define PG8_LDB(dst, b, h) do { _Pragma("unroll") for (int n = 0; n < 2; ++n) _Pragma("unroll") for (int k = 0; k < 2; ++k) dst[n][k] = *(const PG8_LAS bf16x8*)(lds + PG8_SB(b, h) + boff + n * 2048 + k * 1024); } while (0)
#define PG8_MMA(ai, bj, At, Bt) do { __builtin_amdgcn_s_setprio(1); _Pragma("unroll") for (int m = 0; m < 4; ++m) _Pragma("unroll") for (int n = 0; n < 2; ++n) _Pragma("unroll") for (int k = 0; k < 2; ++k) \
        acc[ai][bj][m][n] = __builtin_amdgcn_mfma_f32_16x16x32_bf16(Bt[n][k], At[m][k], acc[ai][bj][m][n], 0, 0, 0); __builtin_amdgcn_s_setprio(0); } while (0)
#define PG8_WAIT_V(n) asm volatile("s_waitcnt vmcnt(" #n ")" ::: "memory")
#define PG8_WAIT_L(n) asm volatile("s_waitcnt lgkmcnt(" #n ")" ::: "memory")
#define PG8_BAR __builtin_amdgcn_s_barrier()
#define PG8_SCHED __builtin_amdgcn_sched_barrier(0)
    Unit cur, nxt; int ui = 0;
    if (!S.next(0, cur)) return;
    f32x4 acc[2][2][4][2];
#pragma unroll
    for (int a = 0; a < 2; ++a)
#pragma unroll
        for (int b = 0; b < 2; ++b)
#pragma unroll
            for (int m = 0; m < 4; ++m)
#pragma unroll
                for (int n = 0; n < 2; ++n) acc[a][b][m][n] = (f32x4){0.f, 0.f, 0.f, 0.f};
    bf16x8 At[4][2], B0[2][2], B1[2][2];
    const char* cA = (const char*)g.A + (size_t)cur.pm * tstep; const char* cB = (const char*)g.Bt + (size_t)cur.pn * tstep;
    S.a_ready(cur);
    if constexpr (SP2) {
        PG8_STAGE(PG8_SB(0, 0), cB, voffB); PG8_STAGE(PG8_SB(0, 1), cB + hstep, voffB); PG8_STAGE(PG8_SA(0, 0), cA, voffA); PG8_STAGE(PG8_SA(0, 1), cA + hstep, voffA);
        if (wr == 1) PG8_BAR;
        PG8_WAIT_V(2); PG8_BAR;
        PG8_STAGE(PG8_SB(1, 0), cB + kstep, voffB); PG8_STAGE(PG8_SA(1, 0), cA + kstep, voffA); PG8_STAGE(PG8_SB(1, 1), cB + hstep + kstep, voffB);
        PG8_WAIT_V(6); PG8_BAR;
    } else {
        PG8_STAGE(PG8_SB(0, 0), cB, voffB); PG8_STAGE(PG8_SA(0, 0), cA, voffA); PG8_STAGE(PG8_SB(0, 1), cB + hstep, voffB); PG8_STAGE(PG8_SA(0, 1), cA + hstep, voffA);
        if (wr == 1) PG8_BAR;
        PG8_WAIT_V(4); PG8_BAR;
        PG8_STAGE(PG8_SB(1, 0), cB + kstep, voffB); PG8_STAGE(PG8_SA(1, 0), cA + kstep, voffA); PG8_STAGE(PG8_SB(1, 1), cB + hstep + kstep, voffB);
        PG8_WAIT_V(6); PG8_BAR;
    }
    for (;;) {
        const bool has_next = S.next(ui + 1, nxt);
        const char* nA = has_next ? (const char*)g.A + (size_t)nxt.pm * tstep : cA; const char* nB = has_next ? (const char*)g.Bt + (size_t)nxt.pn * tstep : cB;
        for (int t = 0; t < nt; t += 2) {
            const bool last = (t == nt - 2);
            const char* a1 = cA + (size_t)(t + 1) * kstep;
            const char* a2 = last ? nA : cA + (size_t)(t + 2) * kstep; const char* b2 = last ? nB : cB + (size_t)(t + 2) * kstep;
            const char* a3 = a2 + kstep; const char* b3 = b2 + kstep;
            if (last && has_next) S.a_ready(nxt);
            if constexpr (SP2) {
            PG8_LDB(B0, 0, 0); PG8_LDB(B1, 0, 1); PG8_SCHED; PG8_LDA(At, 0, 0); PG8_STAGE(PG8_SA(1, 1), a1 + hstep, voffA);
            PG8_WAIT_V(8); PG8_WAIT_L(0); PG8_BAR; PG8_MMA(0, 0, At, B0); PG8_MMA(0, 1, At, B1); PG8_BAR; PG8_SCHED;
            PG8_LDA(At, 0, 1); PG8_STAGE(PG8_SB(0, 0), b2, voffB); PG8_STAGE(PG8_SB(0, 1), b2 + hstep, voffB); PG8_STAGE(PG8_SA(0, 0), a2, voffA);
            PG8_WAIT_V(8); PG8_WAIT_L(0); PG8_BAR; PG8_MMA(1, 0, At, B0); PG8_MMA(1, 1, At, B1); PG8_BAR; PG8_SCHED;
            PG8_LDB(B0, 1, 0); PG8_LDB(B1, 1, 1); PG8_SCHED; PG8_LDA(At, 1, 0); PG8_STAGE(PG8_SA(0, 1), a2 + hstep, voffA);
            PG8_WAIT_V(8); PG8_WAIT_L(0); PG8_BAR; PG8_MMA(0, 0, At, B0); PG8_MMA(0, 1, At, B1); PG8_BAR; PG8_SCHED;
            PG8_LDA(At, 1, 1); PG8_STAGE(PG8_SB(1, 0), b3, voffB); PG8_STAGE(PG8_SB(1, 1), b3 + hstep, voffB); PG8_STAGE(PG8_SA(1, 0), a3, voffA);
            PG8_WAIT_V(8); PG8_WAIT_L(0); PG8_BAR; PG8_MMA(1, 0, At, B0); PG8_MMA(1, 1, At, B1); PG8_BAR; PG8_SCHED;
            } else {
            PG8_LDB(B0, 0, 0); PG8_SCHED; PG8_LDA(At, 0, 0); PG8_STAGE(PG8_SA(1, 1), a1 + hstep, voffA);
            PG8_WAIT_L(8); PG8_BAR; PG8_WAIT_L(0); PG8_MMA(0, 0, At, B0); PG8_BAR; PG8_SCHED;
            PG8_LDB(B1, 0, 1); PG8_STAGE(PG8_SB(0, 0), b2, voffB);
            PG8_BAR; PG8_WAIT_L(0); PG8_MMA(0, 1, At, B1); PG8_BAR;
            PG8_LDA(At, 0, 1); PG8_STAGE(PG8_SA(0, 0), a2, voffA);
            PG8_BAR; PG8_WAIT_L(0); PG8_MMA(1, 0, At, B0); PG8_BAR; PG8_SCHED;
            PG8_STAGE(PG8_SB(0, 1), b2 + hstep, voffB);
            PG8_WAIT_V(6); PG8_BAR; PG8_MMA(1, 1, At, B1); PG8_BAR;
            PG8_LDB(B0, 1, 0); PG8_SCHED; PG8_LDA(At, 1, 0); PG8_STAGE(PG8_SA(0, 1), a2 + hstep, voffA);
            PG8_WAIT_L(8); PG8_BAR; PG8_WAIT_L(0); PG8_MMA(0, 0, At, B0); PG8_BAR; PG8_SCHED;
            PG8_LDB(B1, 1, 1); PG8_STAGE(PG8_SB(1, 0), b3, voffB);
            PG8_BAR; PG8_WAIT_L(0); PG8_MMA(0, 1, At, B1); PG8_BAR;
            PG8_LDA(At, 1, 1); PG8_STAGE(PG8_SA(1, 0), a3, voffA);
            PG8_BAR; PG8_WAIT_L(0); PG8_MMA(1, 0, At, B0); PG8_BAR; PG8_SCHED;
            PG8_STAGE(PG8_SB(1, 1), b3 + hstep, voffB);
            PG8_WAIT_V(6); PG8_BAR; PG8_MMA(1, 1, At, B1); PG8_BAR;
            }
        }
        if constexpr (ALIGN_EPI) { if (wr == 0) PG8_BAR; }
        if constexpr (!Epi::AFTER_DRAIN) { E(acc, cur, wr, wc, fr, fq); S.done(cur); }
        if (!has_next) break;
#pragma unroll
        for (int a = 0; a < 2; ++a)
#pragma unroll
            for (int b = 0; b < 2; ++b)
#pragma unroll
                for (int m = 0; m < 4; ++m)
#pragma unroll
                    for (int n = 0; n < 2; ++n) acc[a][b][m][n] = (f32x4){0.f, 0.f, 0.f, 0.f};
        cur = nxt; cA = nA; cB = nB; ++ui;
        if constexpr (ALIGN_EPI) { if (wr == 1) PG8_BAR; }
    }
    PG8_WAIT_V(0);
    if constexpr (!ALIGN_EPI) { if (wr == 0) PG8_BAR; }
    PG8_BAR;
    if constexpr (Epi::AFTER_DRAIN) { E.fused(acc, cur, wr, wc, fr, fq, lds, wid, lane); S.done(cur); }
#undef PG8_SA
#undef PG8_SB
#undef PG8_STAGE
#undef PG8_LDA
#undef PG8_LDB
#undef PG8_MMA
#undef PG8_WAIT_V
#undef PG8_WAIT_L
#undef PG8_BAR
#undef PG8_SCHED
}
}
#define LAS __attribute__((address_space(3)))
typedef unsigned short bf16_t;
typedef short bf16x8 __attribute__((ext_vector_type(8)));
typedef short s16x4 __attribute__((ext_vector_type(4)));
typedef float f32x4 __attribute__((ext_vector_type(4)));
typedef float f32x16 __attribute__((ext_vector_type(16)));
typedef unsigned u32x4 __attribute__((ext_vector_type(4)));
typedef unsigned u32x2 __attribute__((ext_vector_type(2)));

constexpr int DM = 1024, NBATCH = 8, SEQ = 4096, DBATCH = 16, DSEQ = 64, PAST = 2048;
constexpr int MP = NBATCH * SEQ, MS = DBATCH * DSEQ, MT = MP + MS;
constexpr int DIN = 9216;
constexpr float EPS = 1e-6f;
constexpr float QSCALE = 0.125f * 1.4426950408889634f;
constexpr size_t ACT = (size_t)MT * DM;
constexpr size_t O_YP = 0, O_YS = (size_t)MP * DM, O_KP = O_YS + (size_t)MS * DM, O_VP = O_KP + 2 * (size_t)MP * DM,
                 O_KS = O_VP + 2 * (size_t)MP * DM, O_VS = O_KS + 2 * (size_t)MS * DM, O_MV = O_VS + 2 * (size_t)MS * DM;
constexpr size_t MiB = 1u << 20;
constexpr size_t WS_CTL = 0;
constexpr size_t WS_WIN = 1 * MiB, WS_WPA = 37 * MiB, WS_WPB = 41 * MiB, WS_WOUT = 45 * MiB, WS_WSB = 49 * MiB;
constexpr size_t WS_XB = 50 * MiB, WS_X1 = 116 * MiB, WS_ACT = 248 * MiB;
constexpr size_t ACT_BYTES = 66 * MiB;
constexpr size_t WS_PART = WS_ACT + 10 * ACT_BYTES;
constexpr size_t WS_XB1 = WS_PART + 16 * MiB;
constexpr size_t WS_END = WS_XB1 + 66 * MiB;
static_assert(ACT * 2 == ACT_BYTES, "act size");
enum { A_UZ = 0, A_AV, A_QB, A_KB, A_VB, A_BZ, A_SGA, A_SGB, A_YA, A_YB };
constexpr int LDS_BYTES = 135168;

__device__ __forceinline__ float bf2f(unsigned v) { return __uint_as_float(v << 16); }
__device__ __forceinline__ unsigned f2bf(float f) { unsigned u = __float_as_uint(f); return (u + 0x7fffu + ((u >> 16) & 1u)) >> 16; }
__device__ __forceinline__ unsigned pk2(float lo, float hi) { return pg8::cvt_pk_bf16(lo, hi); }
__device__ __forceinline__ float fexp2(float x) { return __builtin_amdgcn_exp2f(x); }
__device__ __forceinline__ float frcp(float x) { return __builtin_amdgcn_rcpf(x); }
__device__ __forceinline__ float sigm(float x) { return frcp(1.f + fexp2(-1.4426950409f * x)); }
__device__ __forceinline__ float silu(float x) { return x * sigm(x); }
__device__ __forceinline__ float gelu_t(float x) { const float u = x + 0.044715f * x * x * x; return x * frcp(1.f + fexp2(-2.3022082f * u)); }
__device__ __forceinline__ float gelu_silu(float u, float z) { const float w = u + 0.044715f * u * u * u; const float d = (1.f + fexp2(-2.3022082f * w)) * (1.f + fexp2(-1.4426950409f * z)); return (u * z) * frcp(d); }
__device__ __forceinline__ float wave_sum(float v) {
#pragma unroll
    for (int o = 1; o < 64; o <<= 1) v += __shfl_xor(v, o);
    return v;
}

namespace pg8 {
struct EpiIn {
    static constexpr bool PERM = true, AFTER_DRAIN = false;
    const float* xpart; float* avpart; bf16_t* act; float *kp, *vp, *ks, *vs;
    __device__ __forceinline__ float rinv_of(int row, int fq) const { const f32x4 q = *(const f32x4*)(xpart + ((size_t)fq * MT + row) * 4);     float s = (q[0] + q[1]) + (q[2] + q[3]); s += __shfl_xor(s, 16); s += __shfl_xor(s, 32); return __builtin_amdgcn_rsqf(s * (1.f / 1024.f) + EPS); }
    template <int SEC> __device__ __forceinline__ void body(const f32x4 (&acc)[2][2][4][2], const Unit& u, int rowb, int cb, int wc, int fq) const {
        bf16_t* dst = act + (size_t)(SEC + 1) * ACT;
#pragma unroll
        for (int ai = 0; ai < 2; ++ai)
#pragma unroll
            for (int m = 0; m < 4; ++m) {
                const int row = rowb + ai * HALF + m * 16;
                const float r = rinv_of(row, fq);
                float ssq = 0.f;
#pragma unroll
                for (int bj = 0; bj < 2; ++bj) {
                    f32x4 v0 = acc[ai][bj][m][0] * r, v1 = acc[ai][bj][m][1] * r;
                    const int col = cb + bj * HALF;
                    if (SEC == 0) {
#pragma unroll
                        for (int j = 0; j < 4; ++j) { v0[j] = gelu_t(v0[j]); v1[j] = gelu_t(v1[j]); ssq += v0[j] * v0[j] + v1[j] * v1[j]; }
                    } else if (SEC == 1) { v0 = v0 * QSCALE; v1 = v1 * QSCALE; }
                    else if (SEC == 2 || SEC == 3) {
                        float* o = (SEC == 2) ? (row < MP ? kp + (size_t)row * DM : ks + (size_t)(row - MP) * DM) : (row < MP ? vp + (size_t)row * DM : vs + (size_t)(row - MP) * DM);
                        *(f32x4*)(o + col) = v0; *(f32x4*)(o + col + 4) = v1;
                    } else if (SEC == 4) {
#pragma unroll
                        for (int j = 0; j < 4; ++j) { v0[j] = silu(v0[j]); v1[j] = silu(v1[j]); }
                    } else {
#ifndef RAW_GATE
#pragma unroll
                        for (int j = 0; j < 4; ++j) { v0[j] = sigm(v0[j]); v1[j] = sigm(v1[j]); }
#endif
                    }
                    u32x4 w; w.x = cvt_pk_bf16(v0[0], v0[1]); w.y = cvt_pk_bf16(v0[2], v0[3]); w.z = cvt_pk_bf16(v1[0], v1[1]); w.w = cvt_pk_bf16(v1[2], v1[3]);
                    *(u32x4*)(dst + (size_t)row * DM + col) = w;
                }
                if (SEC == 0) { ssq += __shfl_xor(ssq, 16); ssq += __shfl_xor(ssq, 32); if (fq == 0) avpart[((size_t)((u.pn - 8) & 3) * MT + row) * 4 + wc] = ssq; }
            }
    }
    __device__ __forceinline__ void operator()(const f32x4 (&acc)[2][2][4][2], const Unit& u, int wr, int wc, int fr, int fq) const {
        const int pn = u.pn, rowb = u.pm * BM + wr * 64 + fr, cl = wc * 32 + 8 * fq;
        if (pn < 8) {
#pragma unroll
            for (int ai = 0; ai < 2; ++ai)
#pragma unroll
                for (int m = 0; m < 4; ++m) {
                    const int row = rowb + ai * HALF + m * 16;
                    const float r = rinv_of(row, fq);
                    const f32x4 u0 = acc[ai][0][m][0] * r, u1 = acc[ai][0][m][1] * r, z0 = acc[ai][1][m][0] * r, z1 = acc[ai][1][m][1] * r;
                    f32x4 o0, o1;
#pragma unroll
                    for (int j = 0; j < 4; ++j) { o0[j] = gelu_silu(u0[j], z0[j]); o1[j] = gelu_silu(u1[j], z1[j]); }
                    u32x4 w; w.x = cvt_pk_bf16(o0[0], o0[1]); w.y = cvt_pk_bf16(o0[2], o0[3]); w.z = cvt_pk_bf16(o1[0], o1[1]); w.w = cvt_pk_bf16(o1[2], o1[3]);
                    *(u32x4*)(act + (size_t)row * DM + pn * HALF + cl) = w;
                }
        } else {
            const int sec = (pn - 8) >> 2, cb = ((pn - 8) & 3) * BM + cl;
            switch (sec) {
                case 0: body<0>(acc, u, rowb, cb, wc, fq); break;
                case 1: body<1>(acc, u, rowb, cb, wc, fq); break;
                case 2: body<2>(acc, u, rowb, cb, wc, fq); break;
                case 3: body<3>(acc, u, rowb, cb, wc, fq); break;
                case 4: body<4>(acc, u, rowb, cb, wc, fq); break;
                case 5: body<5>(acc, u, rowb, cb, wc, fq); break;
                default: body<6>(acc, u, rowb, cb, wc, fq); break;
            }
        }
    }
};
template <int MODE> struct EpiGate {
    static constexpr bool PERM = true, AFTER_DRAIN = false;
    const bf16_t* gate; const bf16_t* prev; bf16_t* out;
    __device__ __forceinline__ void operator()(const f32x4 (&acc)[2][2][4][2], const Unit& u, int wr, int wc, int fr, int fq) const {
        const int rowb = u.pm * BM + wr * 64 + fr, cb = u.pn * BM + wc * 32 + 8 * fq;
#pragma unroll
        for (int ai = 0; ai < 2; ++ai)
#pragma unroll
            for (int m = 0; m < 4; ++m) {
                const size_t ro = (size_t)(rowb + ai * HALF + m * 16) * DM;
#pragma unroll
                for (int bj = 0; bj < 2; ++bj) {
                    const size_t off = ro + cb + bj * HALF;
#ifdef NO_GATE
                    const u32x4 g = (u32x4){0x3f803f80u, 0x3f803f80u, 0x3f803f80u, 0x3f803f80u};
#else
                    const u32x4 g = *(const u32x4*)(gate + off);
#endif
                    f32x4 v0 = acc[ai][bj][m][0], v1 = acc[ai][bj][m][1];
                    v0[0] *= bf2f(g.x & 0xffffu); v0[1] *= bf2f(g.x >> 16); v0[2] *= bf2f(g.y & 0xffffu); v0[3] *= bf2f(g.y >> 16);
                    v1[0] *= bf2f(g.z & 0xffffu); v1[1] *= bf2f(g.z >> 16); v1[2] *= bf2f(g.w & 0xffffu); v1[3] *= bf2f(g.w >> 16);
                    if (MODE == 1) { const u32x4 q = *(const u32x4*)(prev + off);
                        v0[0] += bf2f(q.x & 0xffffu); v0[1] += bf2f(q.x >> 16); v0[2] += bf2f(q.y & 0xffffu); v0[3] += bf2f(q.y >> 16);
                        v1[0] += bf2f(q.z & 0xffffu); v1[1] += bf2f(q.z >> 16); v1[2] += bf2f(q.w & 0xffffu); v1[3] += bf2f(q.w >> 16); }
                    u32x4 w; w.x = cvt_pk_bf16(v0[0], v0[1]); w.y = cvt_pk_bf16(v0[2], v0[3]); w.z = cvt_pk_bf16(v1[0], v1[1]); w.w = cvt_pk_bf16(v1[2], v1[3]);
                    *(u32x4*)(out + off) = w;
                }
                asm volatile("" ::: "memory");
            }
    }
};
struct EpiRes {
    static constexpr bool PERM = true, AFTER_DRAIN = false;
    const float* xp; const float* xs;
    float* x1; bf16_t* xb; float* ssq; int next;
    __device__ __forceinline__ void operator()(const f32x4 (&acc)[2][2][4][2], const Unit& u, int wr, int wc, int fr, int fq) const {
        const int rowb = u.pm * BM + wr * 64 + fr, cb = u.pn * BM + wc * 32 + 8 * fq;
#pragma unroll
        for (int ai = 0; ai < 2; ++ai)
#pragma unroll
            for (int m = 0; m < 4; ++m) {
                const int row = rowb + ai * HALF + m * 16;
                const float* src = row < MP ? xp + (size_t)row * DM : xs + (size_t)(row - MP) * DM;
                float s = 0.f;
#pragma unroll
                for (int bj = 0; bj < 2; ++bj) {
                    const int col = cb + bj * HALF;
                    const f32x4 v0 = acc[ai][bj][m][0] + *(const f32x4*)(src + col), v1 = acc[ai][bj][m][1] + *(const f32x4*)(src + col + 4);
                    *(f32x4*)(x1 + (size_t)row * DM + col) = v0; *(f32x4*)(x1 + (size_t)row * DM + col + 4) = v1;
                    if (next) {
                        u32x4 w; w.x = cvt_pk_bf16(v0[0], v0[1]); w.y = cvt_pk_bf16(v0[2], v0[3]); w.z = cvt_pk_bf16(v1[0], v1[1]); w.w = cvt_pk_bf16(v1[2], v1[3]);
                        *(u32x4*)(xb + (size_t)row * DM + col) = w;
#pragma unroll
                        for (int j = 0; j < 4; ++j) s += v0[j] * v0[j] + v1[j] * v1[j];
                    }
                }
                if (next) { s += __shfl_xor(s, 16); s += __shfl_xor(s, 32); if (fq == 0) ssq[((size_t)u.pn * MT + row) * 4 + wc] = s; }
                asm volatile("" ::: "memory");
            }
    }
};
}
__device__ __forceinline__ void tr_item(const float* W, int N, int ncol0, int k0, const float* kscale, bf16_t* WTrow0, LAS float* scr, int lane) {
#pragma unroll 8
    for (int i = 0; i < 32; ++i) { const int kk = 2 * i + (lane >> 5); float v = W[(size_t)(k0 + kk) * N + ncol0 + (lane & 31)]; if (kscale) v *= kscale[k0 + kk]; scr[kk * 33 + (lane & 31)] = v; }
    asm volatile("s_waitcnt lgkmcnt(0)" ::: "memory");
    const int c = lane & 7;
#pragma unroll
    for (int j = 0; j < 4; ++j) { const int n = (lane >> 3) + 8 * j; const LAS float* s = scr + (8 * c) * 33 + n;
        u32x4 o; o.x = pk2(s[0 * 33], s[1 * 33]); o.y = pk2(s[2 * 33], s[3 * 33]); o.z = pk2(s[4 * 33], s[5 * 33]); o.w = pk2(s[6 * 33], s[7 * 33]);
        *(u32x4*)(WTrow0 + (size_t)n * DM + k0 + 8 * c) = o; }
    asm volatile("s_waitcnt lgkmcnt(0)" ::: "memory");
}
struct Params { const float* in[18]; float* out; unsigned char* ws; int ph_lo, ph_hi; };

typedef const __attribute__((address_space(4))) Params* KArgsP;
__device__ __forceinline__ void phase_prologue(KArgsP kp, LAS unsigned char* lds) {
    int tid_ = threadIdx.x; asm volatile("" : "+v"(tid_)); const int tid = tid_, lane = tid & 63, wave = tid >> 6, G = gridDim.x;
    const int gw = blockIdx.x * 8 + wave, NGW = G * 8;
    LAS float* scr = (LAS float*)(lds + wave * 8448);
    float* ctl = (float*)(kp->ws + WS_CTL);
    float* xpart = (float*)(kp->ws + WS_PART);
    constexpr int I_IN = 16 * 288, I_P = 16 * 32, I_L = I_IN + 3 * I_P;
    for (int it = gw; it < 2 * I_L; it += NGW) {
        const int li = it / I_L; int r = it % I_L;
        if (r < I_IN) {
            const int kb = r / 288, nb = r % 288, d0 = nb * 32;
            int src;
            if (d0 < 2048) { const int t = d0 >> 8, wi = d0 & 255; src = wi < 128 ? 128 * t + wi : 2048 + 128 * t + (wi - 128); }
            else if (d0 < 3072) src = d0 - 1024;
            else src = d0;
            tr_item(kp->in[5] + (size_t)li * DM * DIN, DIN, src, kb * 64, kp->in[4] + li * DM, (bf16_t*)(kp->ws + WS_WIN) + ((size_t)li * DIN + d0) * DM, scr, lane);
        } else {
            r -= I_IN; const int which = r / I_P; r %= I_P; const int kb = r / 32, nb = r % 32;
            const float* W = kp->in[14 + which] + (size_t)li * DM * DM;
            bf16_t* WT = (bf16_t*)(kp->ws + (which == 0 ? WS_WPA : which == 1 ? WS_WPB : WS_WOUT)) + ((size_t)li * DM + nb * 32) * DM;
            tr_item(W, DM, nb * 32, kb * 64, nullptr, WT, scr, lane);
        }
    }
    bf16_t* XB = (bf16_t*)(kp->ws + WS_XB);
    for (int m = gw; m < MT; m += NGW) {
        const float* xr = m < MP ? kp->in[0] + (size_t)m * DM : kp->in[1] + (size_t)(m - MP) * DM;
        f32x4 v[4]; float s = 0.f;
#pragma unroll
        for (int j = 0; j < 4; ++j) { v[j] = *(const f32x4*)(xr + 256 * j + 4 * lane); s += v[j][0] * v[j][0] + v[j][1] * v[j][1] + v[j][2] * v[j][2] + v[j][3] * v[j][3]; }
        s = wave_sum(s);
#pragma unroll
        for (int j = 0; j < 4; ++j) { u32x2 w; w.x = pk2(v[j][0], v[j][1]); w.y = pk2(v[j][2], v[j][3]); *(u32x2*)(XB + (size_t)m * DM + 256 * j + 4 * lane) = w; }
        if (lane < 16) xpart[((size_t)(lane >> 2) * MT + m) * 4 + (lane & 3)] = s * (1.f / 16.f);
    }
    const int gt = blockIdx.x * 512 + tid, NGT = G * 512;
    bf16_t* WSB = (bf16_t*)(kp->ws + WS_WSB);
    for (int i = gt; i < 2 * 4 * 128 * 128; i += NGT) { const int s = i & 127, t = (i >> 7) & 127; WSB[i] = (bf16_t)(s <= t ? f2bf(kp->in[6][i]) : 0u); }
    if (blockIdx.x == 0 && wave == 0) {
        for (int li = 0; li < 2; ++li) {
            const float d1 = wave_sum(kp->in[9][li * 64 + lane] * kp->in[10][li * 64 + lane]);
            const float d2 = wave_sum(kp->in[11][li * 64 + lane] * kp->in[12][li * 64 + lane]);
            const float lam_init = 0.8f - 0.6f * expf(-0.3f * (float)li);
            if (lane == 0) ctl[li] = expf(d1) - expf(d2) + lam_init;
        }
    }
}

constexpr int KP = 272, VP = 320, KIMG = 64 * KP, VIMG = 64 * VP;
constexpr int L_K0 = 0, L_V0 = 2 * KIMG, L_WSF = L_V0 + 2 * VIMG, L_ATT_END = L_WSF + 2048;
static_assert(L_ATT_END <= LDS_BYTES && 128 * 128 * 4 <= L_WSF, "attention LDS map");
__device__ __forceinline__ int crow(int i, int h) { return (i & 3) + 8 * (i >> 2) + 4 * h; }
typedef short v4i16_t __attribute__((ext_vector_type(4)));
__device__ __forceinline__ s16x4 trr(const LAS unsigned char* p) { return __builtin_bit_cast(s16x4, __builtin_amdgcn_ds_read_tr16_b64_v4i16((LAS v4i16_t*)p)); }
#define MFMA32(a, b, c) __builtin_amdgcn_mfma_f32_32x32x16_bf16((a), (b), (c), 0, 0, 0)

struct AttnArgs { const bf16_t *QB, *KB, *VB, *BZ; bf16_t* YB; const float *ck, *cv, *nks, *nvs; const float* ang; float lam, post; };

template <bool SAMPLE>
__device__ __forceinline__ void attn_unit(LAS unsigned char* lds, const AttnArgs& A, int b, int h, int qb) {
    constexpr int ND = SAMPLE ? 2 : 4;
    int tid_ = threadIdx.x; asm volatile("" : "+v"(tid_)); const int tid = tid_, lane = tid & 63, w = __builtin_amdgcn_readfirstlane(tid >> 6), r = lane & 31, hh = lane >> 5;
    const int map = w >> 2, wq = SAMPLE ? ((w >> 1) & 1) : (w & 3), dbase = SAMPLE ? (w & 1) * 2 : 0;
    const int NT = SAMPLE ? 33 : 2 * qb + 2;
    const int ntw = SAMPLE ? 33 : 2 * qb + 1 + (wq >> 1);
    const size_t qrow0 = SAMPLE ? (size_t)MP + (size_t)b * DSEQ : (size_t)b * SEQ + (size_t)qb * 128;
    bf16x8 qf[4];
    { const size_t qr = qrow0 + wq * 32 + r; const bf16_t* qp = A.QB + qr * DM + h * 128 + map * 64 + hh * 8;
#pragma unroll
      for (int ds = 0; ds < 4; ++ds) qf[ds] = *(const bf16x8*)(qp + ds * 16); }
    const int lr = tid >> 4, c16 = tid & 15;
    u32x4 kst[2], vst[2];
    f32x4 ksf[2][2], vsf[2][2];
    auto issue = [&](int t) {
        if (!SAMPLE) {
            const size_t base = ((size_t)b * SEQ + (size_t)t * 64 + lr) * DM + h * 128 + c16 * 8;
#pragma unroll
            for (int i = 0; i < 2; ++i) { kst[i] = *(const u32x4*)(A.KB + base + (size_t)i * 32 * DM); vst[i] = *(const u32x4*)(A.VB + base + (size_t)i * 32 * DM); }
        } else {
            const size_t off = (size_t)lr * DM + h * 128 + c16 * 8;
            if (t < 32) {
                const float* kb = A.ck + ((size_t)b * PAST + (size_t)t * 64) * DM;
                const float* vb = A.cv + ((size_t)b * PAST + (size_t)t * 64) * DM;
#pragma unroll
                for (int i = 0; i < 2; ++i) { ksf[i][0] = *(const f32x4*)(kb + off + (size_t)i * 32 * DM); ksf[i][1] = *(const f32x4*)(kb + off + (size_t)i * 32 * DM + 4);
                                              vsf[i][0] = *(const f32x4*)(vb + off + (size_t)i * 32 * DM); vsf[i][1] = *(const f32x4*)(vb + off + (size_t)i * 32 * DM + 4); }
            } else {
                const bf16_t* kb = A.KB + ((size_t)MP + (size_t)b * DSEQ) * DM;
                const bf16_t* vb = A.VB + ((size_t)MP + (size_t)b * DSEQ) * DM;
#pragma unroll
                for (int i = 0; i < 2; ++i) {
                    const u32x4 kr = *(const u32x4*)(kb + off + (size_t)i * 32 * DM), vr = *(const u32x4*)(vb + off + (size_t)i * 32 * DM);
                    ksf[i][0] = (f32x4){bf2f(kr.x & 0xffffu), bf2f(kr.x >> 16), bf2f(kr.y & 0xffffu), bf2f(kr.y >> 16)}; ksf[i][1] = (f32x4){bf2f(kr.z & 0xffffu), bf2f(kr.z >> 16), bf2f(kr.w & 0xffffu), bf2f(kr.w >> 16)};
                    vsf[i][0] = (f32x4){bf2f(vr.x & 0xffffu), bf2f(vr.x >> 16), bf2f(vr.y & 0xffffu), bf2f(vr.y >> 16)}; vsf[i][1] = (f32x4){bf2f(vr.z & 0xffffu), bf2f(vr.z >> 16), bf2f(vr.w & 0xffffu), bf2f(vr.w >> 16)};
                }
            }
        }
    };
    auto commit = [&](int buf) {
#pragma unroll
        for (int i = 0; i < 2; ++i) {
            u32x4 kw, vw;
            if (!SAMPLE) { kw = kst[i]; vw = vst[i]; }
            else { kw.x = pk2(ksf[i][0][0], ksf[i][0][1]); kw.y = pk2(ksf[i][0][2], ksf[i][0][3]); kw.z = pk2(ksf[i][1][0], ksf[i][1][1]); kw.w = pk2(ksf[i][1][2], ksf[i][1][3]);
                   vw.x = pk2(vsf[i][0][0], vsf[i][0][1]); vw.y = pk2(vsf[i][0][2], vsf[i][0][3]); vw.z = pk2(vsf[i][1][0], vsf[i][1][1]); vw.w = pk2(vsf[i][1][2], vsf[i][1][3]); }
            *(LAS u32x4*)(lds + L_K0 + buf * KIMG + (lr + 32 * i) * KP + c16 * 16) = kw;
            *(LAS u32x4*)(lds + L_V0 + buf * VIMG + (lr + 32 * i) * VP + c16 * 16) = vw;
        }
    };
    LAS float* wsf = (LAS float*)(lds + L_WSF) + w * 64;
    f32x16 o[ND];
#pragma unroll
    for (int d = 0; d < ND; ++d)
#pragma unroll
        for (int i = 0; i < 16; ++i) o[d][i] = 0.f;
    float mrun = 0.f, lrun = 0.f;
    f32x16 negm;
#pragma unroll
    for (int i = 0; i < 16; ++i) negm[i] = 0.f;
    const int q4 = (lane & 15) >> 2, pp = lane & 3, blk = (lane >> 4) & 1;
    const int koff = map * 128 + r * KP + hh * 16, voff = (4 * hh + q4) * VP + blk * 32 + pp * 8 + dbase * 64;

    issue(0); commit(0); __syncthreads();
    for (int t = 0; t < NT; ++t) {
        const int buf = t & 1;
        if (t + 1 < NT) issue(t + 1);
        if (t < ntw) {
            const LAS unsigned char* kb = lds + L_K0 + buf * KIMG + koff;
            f32x16 p0, p1;
#pragma unroll
            for (int ds = 0; ds < 4; ++ds) {
                const bf16x8 k0 = *(const LAS bf16x8*)(kb + ds * 32), k1 = *(const LAS bf16x8*)(kb + 32 * KP + ds * 32);
                if (ds == 0) { p0 = MFMA32(k0, qf[0], negm); p1 = MFMA32(k1, qf[0], negm); }
                else { p0 = MFMA32(k0, qf[ds], p0); p1 = MFMA32(k1, qf[ds], p1); }
            }
            float mx = fmaxf(p0[0], p1[0]);
#pragma unroll
            for (int i = 1; i < 16; ++i) mx = fmaxf(mx, fmaxf(p0[i], p1[i]));
            mx = fmaxf(mx, __shfl_xor(mx, 32));
            const bool first = (t == 0);
            if (first || __any(mx > 8.f)) {
                const float dl = first ? mx : fmaxf(mx, 0.f);
                const float al = first ? 1.f : fexp2(-dl);
                lrun *= al; mrun += dl;
#pragma unroll
                for (int i = 0; i < 16; ++i) { p0[i] -= dl; p1[i] -= dl; negm[i] = -mrun; }
                if (!first) {
                    if (hh == 0) wsf[r] = al;
                    asm volatile("s_waitcnt lgkmcnt(0)" ::: "memory");
#pragma unroll
                    for (int g = 0; g < 4; ++g) { const f32x4 a4 = *(const LAS f32x4*)(wsf + 8 * g + 4 * hh);
#pragma unroll
                        for (int d = 0; d < ND; ++d)
#pragma unroll
                            for (int j = 0; j < 4; ++j) o[d][4 * g + j] *= a4[j]; }
                }
            }
            float ls = 0.f;
#pragma unroll
            for (int i = 0; i < 16; ++i) { p0[i] = fexp2(p0[i]); p1[i] = fexp2(p1[i]); ls += p0[i] + p1[i]; }
            lrun += ls;
            bf16x8 pa[4];
#pragma unroll
            for (int s = 0; s < 4; ++s) {
                u32x4 pw;
                if (s < 2) { pw.x = pk2(p0[8 * s + 0], p0[8 * s + 1]); pw.y = pk2(p0[8 * s + 2], p0[8 * s + 3]); pw.z = pk2(p0[8 * s + 4], p0[8 * s + 5]); pw.w = pk2(p0[8 * s + 6], p0[8 * s + 7]); }
                else { const int s2 = s - 2; pw.x = pk2(p1[8 * s2 + 0], p1[8 * s2 + 1]); pw.y = pk2(p1[8 * s2 + 2], p1[8 * s2 + 3]); pw.z = pk2(p1[8 * s2 + 4], p1[8 * s2 + 5]); pw.w = pk2(p1[8 * s2 + 6], p1[8 * s2 + 7]); }
                pa[s] = __builtin_bit_cast(bf16x8, pw);
            }
            const LAS unsigned char* vb = lds + L_V0 + buf * VIMG + voff;
#pragma unroll
            for (int d = 0; d < ND; ++d) {
#pragma unroll
                for (int s = 0; s < 4; ++s) {
                    const s16x4 lo = trr(vb + s * 16 * VP + d * 64), hi = trr(vb + s * 16 * VP + 8 * VP + d * 64);
                    const bf16x8 vf = __builtin_shufflevector(lo, hi, 0, 1, 2, 3, 4, 5, 6, 7);
                    o[d] = MFMA32(pa[s], vf, o[d]);
                }
                if (d & 1) __builtin_amdgcn_sched_barrier(0);
            }
        }
        if (t + 1 < NT) commit(buf ^ 1);
        __syncthreads();
    }
    {
        lrun += __shfl_xor(lrun, 32);
        if (hh == 0) wsf[r] = frcp(lrun);
        asm volatile("s_waitcnt lgkmcnt(0)" ::: "memory");
#pragma unroll
        for (int g = 0; g < 4; ++g) { const f32x4 a4 = *(const LAS f32x4*)(wsf + 8 * g + 4 * hh);
#pragma unroll
            for (int d = 0; d < ND; ++d)
#pragma unroll
                for (int j = 0; j < 4; ++j) o[d][4 * g + j] *= a4[j]; }
    }
    LAS float* exch = (LAS float*)lds;
    LAS float* red = (LAS float*)(lds + 65536);
    if (map == 1) {
#pragma unroll
        for (int d = 0; d < ND; ++d)
#pragma unroll
            for (int i = 0; i < 16; ++i) exch[(wq * 32 + crow(i, hh)) * 128 + (dbase + d) * 32 + r] = o[d][i];
    }
    __syncthreads();
    float ss[16];
#pragma unroll
    for (int i = 0; i < 16; ++i) ss[i] = 0.f;
    if (map == 0) {
#pragma unroll
        for (int d = 0; d < ND; ++d)
#pragma unroll
            for (int i = 0; i < 16; ++i) { const float v = o[d][i] - A.lam * exch[(wq * 32 + crow(i, hh)) * 128 + (dbase + d) * 32 + r]; o[d][i] = v; ss[i] += v * v; }
#pragma unroll
        for (int i = 0; i < 16; ++i) {
#pragma unroll
            for (int off = 1; off < 32; off <<= 1) ss[i] += __shfl_xor(ss[i], off);
        }
        if (SAMPLE && r == 0) {
#pragma unroll
            for (int i = 0; i < 16; ++i) red[w * 32 + crow(i, hh)] = ss[i];
        }
    }
    if (SAMPLE) __syncthreads();
    if (map == 0) {
#pragma unroll
        for (int i = 0; i < 16; ++i) {
            if (SAMPLE) ss[i] += red[(w ^ 1) * 32 + crow(i, hh)];
            ss[i] = __builtin_amdgcn_rsqf(ss[i] * (1.f / 128.f) + EPS) * A.post;
        }
#pragma unroll
        for (int d = 0; d < ND; ++d) {
            const float gc = A.ang[(dbase + d) * 32 + r];
#pragma unroll
            for (int i = 0; i < 16; ++i) {
                const size_t idx = (qrow0 + wq * 32 + crow(i, hh)) * DM + h * 128 + (dbase + d) * 32 + r;
                A.YB[idx] = (bf16_t)f2bf(o[d][i] * ss[i] * gc * bf2f(A.BZ[idx]));
            }
        }
    }
    __syncthreads();
}

constexpr int XP = 576, L_RINV = 128 * XP;
__device__ __forceinline__ void spatial_unit(LAS unsigned char* lds, int row0, int nrows, int g, const bf16_t* AV, const bf16_t* UZ, bf16_t* YA,
                                             const float* avssq, const bf16_t* WsB, const float* bsg, const float* vng, float* mlpv) {
    int tid_ = threadIdx.x; asm volatile("" : "+v"(tid_)); const int tid = tid_, lane = tid & 63, w = __builtin_amdgcn_readfirstlane(tid >> 6), r = lane & 31, hh = lane >> 5;
    LAS float* rinv = (LAS float*)(lds + L_RINV);
    if (tid < nrows) { const float* q = avssq + (size_t)(row0 + tid) * 4; const f32x4 a = *(const f32x4*)q, b4 = *(const f32x4*)(q + (size_t)MT * 4), c4 = *(const f32x4*)(q + (size_t)MT * 8), d4 = *(const f32x4*)(q + (size_t)MT * 12);
        const float s = ((a[0] + a[1]) + (a[2] + a[3])) + ((b4[0] + b4[1]) + (b4[2] + b4[3])) + ((c4[0] + c4[1]) + (c4[2] + c4[3])) + ((d4[0] + d4[1]) + (d4[2] + d4[3]));
        rinv[tid] = __builtin_amdgcn_rsqf(s * (1.f / 1024.f) + EPS); }
    __syncthreads();
    for (int i = 0; i < nrows / 16; ++i) {
        const int c = tid + 512 * i, s = c >> 5, c8 = c & 31;
        const u32x4 raw = *(const u32x4*)(AV + (size_t)(row0 + s) * DM + g * 256 + c8 * 8);
        const float ri = rinv[s];
        const f32x4 g0 = *(const f32x4*)(vng + g * 256 + c8 * 8), g1 = *(const f32x4*)(vng + g * 256 + c8 * 8 + 4);
        f32x4 x0, x1;
        x0[0] = bf2f(raw.x & 0xffffu) * ri * g0[0]; x0[1] = bf2f(raw.x >> 16) * ri * g0[1]; x0[2] = bf2f(raw.y & 0xffffu) * ri * g0[2]; x0[3] = bf2f(raw.y >> 16) * ri * g0[3];
        x1[0] = bf2f(raw.z & 0xffffu) * ri * g1[0]; x1[1] = bf2f(raw.z >> 16) * ri * g1[1]; x1[2] = bf2f(raw.w & 0xffffu) * ri * g1[2]; x1[3] = bf2f(raw.w >> 16) * ri * g1[3];
        if (mlpv) { *(f32x4*)(mlpv + (size_t)s * DM + g * 256 + c8 * 8) = x0; *(f32x4*)(mlpv + (size_t)s * DM + g * 256 + c8 * 8 + 4) = x1; }
        u32x4 pw; pw.x = pk2(x0[0], x0[1]); pw.y = pk2(x0[2], x0[3]); pw.z = pk2(x1[0], x1[1]); pw.w = pk2(x1[2], x1[3]);
        *(LAS u32x4*)(lds + s * XP + c8 * 16) = pw;
    }
    __syncthreads();
    const int tb = w & 3, chalf = w >> 2;
    if (tb * 32 < nrows) {
        f32x16 acc[4];
#pragma unroll
        for (int cb = 0; cb < 4; ++cb)
#pragma unroll
            for (int i = 0; i < 16; ++i) acc[cb][i] = 0.f;
        const int q4 = (lane & 15) >> 2, pp = lane & 3, blk = (lane >> 4) & 1;
        const bf16_t* wrow = WsB + (size_t)(32 * tb + r) * 128 + 8 * hh;
        const LAS unsigned char* xb = lds + (8 * hh + q4) * XP + (chalf * 128 + blk * 16) * 2 + pp * 8;
        const int nks = 2 * (tb + 1);
        for (int ks = 0; ks < nks; ++ks) {
            const bf16x8 wb = *(const bf16x8*)(wrow + 16 * ks);
#pragma unroll
            for (int cb = 0; cb < 4; ++cb) {
                const s16x4 lo = trr(xb + ks * 16 * XP + cb * 64), hi = trr(xb + ks * 16 * XP + 4 * XP + cb * 64);
                const bf16x8 xa = __builtin_shufflevector(lo, hi, 0, 1, 2, 3, 4, 5, 6, 7);
                acc[cb] = MFMA32(xa, wb, acc[cb]);
            }
        }
        const int t = 32 * tb + r; const float bs = bsg[t]; const size_t ro = (size_t)(row0 + t) * DM + g * 256 + chalf * 128;
#pragma unroll
        for (int cb = 0; cb < 4; ++cb)
#pragma unroll
            for (int gq = 0; gq < 4; ++gq) {
                const size_t idx = ro + cb * 32 + 8 * gq + 4 * hh;
                const u32x2 uz = *(const u32x2*)(UZ + idx);
                u32x2 ow;
                ow.x = pk2((acc[cb][4 * gq + 0] + bs) * bf2f(uz.x & 0xffffu), (acc[cb][4 * gq + 1] + bs) * bf2f(uz.x >> 16));
                ow.y = pk2((acc[cb][4 * gq + 2] + bs) * bf2f(uz.y & 0xffffu), (acc[cb][4 * gq + 3] + bs) * bf2f(uz.y >> 16));
                *(u32x2*)(YA + idx) = ow;
            }
    }
    __syncthreads();
}
#ifndef ATT_REPS
#define ATT_REPS 1
#endif
#ifndef LIGHT_REPS
#define LIGHT_REPS 1
#endif
#ifndef P1_REPS
#define P1_REPS 1
#endif
#ifndef CONVERT_IN_LOOP
#define CONVERT_IN_LOOP 0
#endif
#ifndef CONVERT_AT_END
#define CONVERT_AT_END 0
#endif
#ifndef SKIP_P0
#define SKIP_P0 0
#endif
#ifndef SKIP_P1
#define SKIP_P1 0
#endif
#ifndef SKIP_P2
#define SKIP_P2 0
#endif
#ifndef SKIP_P3A
#define SKIP_P3A 0
#endif
#ifndef SKIP_P3B
#define SKIP_P3B 0
#endif
typedef const __attribute__((address_space(4))) Params* KArgs;
__device__ __forceinline__ KArgs kargs() { KArgs k = (KArgs)__builtin_amdgcn_kernarg_segment_ptr(); asm volatile("" : "+s"(k)); return k; }
#define KP_DECL() KArgs kp = kargs(); float* ctl = (float*)(kp->ws + WS_CTL); bf16_t* act = (bf16_t*)(kp->ws + WS_ACT); bf16_t* XB = (bf16_t*)(kp->ws + WS_XB); float* X1 = (float*)(kp->ws + WS_X1); (void)ctl; (void)act; (void)XB; (void)X1
__global__ void __launch_bounds__(512, 2) fwd_kernel(Params p) {
    extern __shared__ __attribute__((aligned(16))) unsigned char lds_raw[];
    LAS unsigned char* lds = (LAS unsigned char*)lds_raw;
    cg::grid_group grid = cg::this_grid();
    const int G = gridDim.x, bx = blockIdx.x;
    const int vcu = (G % 8 == 0) ? (bx % 8) * (G / 8) + bx / 8 : bx;
    int ph = 0;
#define PH_IN() (p.ph_lo <= ph && ph < p.ph_hi)
#define PH_END() do { if (p.ph_lo <= ph && ph + 1 < p.ph_hi) { \
        asm volatile("s_waitcnt vmcnt(0) lgkmcnt(0)" ::: "memory");                   \
        __syncthreads(); \
        if ((threadIdx.x >> 6) == 0) { __builtin_amdgcn_fence(__ATOMIC_RELEASE, "agent"); asm volatile("s_waitcnt vmcnt(0)" ::: "memory"); }     \
        grid.sync(); \
        if ((threadIdx.x >> 6) == 0) { __builtin_amdgcn_fence(__ATOMIC_ACQUIRE, "agent"); asm volatile("s_waitcnt vmcnt(0)" ::: "memory"); }     \
        __syncthreads();                                                                                                                         \
    } ++ph; } while (0)
    if (PH_IN() && !SKIP_P0) { KArgs kp = kargs(); phase_prologue(kp, lds); }
    PH_END();
#pragma unroll 1
    for (int li = 0; li < 2; ++li) {
        if (PH_IN() && !SKIP_P1) {
            KP_DECL(); float* xssq_cur = (float*)(kp->ws + WS_PART) + (size_t)li * MT * 16; float* avssq = (float*)(kp->ws + WS_PART) + (size_t)(2 + li) * MT * 16;
            pg8::Gemm g{li == 0 ? XB : (const bf16_t*)(kp->ws + WS_XB1), (const bf16_t*)(kp->ws + WS_WIN) + (size_t)li * DIN * DM, MT, DIN, DM};
            pg8::StaticOrder S; S.init(MT, DIN, G, bx);
            pg8::EpiIn E{xssq_cur, avssq, act, kp->out + O_KP + (size_t)li * MP * DM, kp->out + O_VP + (size_t)li * MP * DM, kp->out + O_KS + (size_t)li * MS * DM, kp->out + O_VS + (size_t)li * MS * DM};
            for (int rep = 0; rep < P1_REPS; ++rep) pg8::gemm_phase<pg8::EpiIn, pg8::StaticOrder, true, true>(lds, g, S, E);
        }
        PH_END();
        if (PH_IN() && !SKIP_P2) {
            KP_DECL(); float* avssq = (float*)(kp->ws + WS_PART) + (size_t)(2 + li) * MT * 16;
            AttnArgs A;
            A.QB = act + A_QB * ACT; A.KB = act + A_KB * ACT; A.VB = act + A_VB * ACT; A.BZ = act + A_BZ * ACT; A.YB = act + A_YB * ACT;
            A.ck = kp->in[2] + (size_t)li * DBATCH * PAST * DM; A.cv = kp->in[3] + (size_t)li * DBATCH * PAST * DM;
            A.nks = kp->out + O_KS + (size_t)li * MS * DM; A.nvs = kp->out + O_VS + (size_t)li * MS * DM;
            A.ang = kp->in[13] + li * 128; A.lam = ctl[li]; A.post = 1.f - (0.8f - 0.6f * expf(-0.3f * (float)li));
            if (CONVERT_IN_LOOP) {
                const unsigned* kb = (const unsigned*)(act + A_KB * ACT); const unsigned* vb = (const unsigned*)(act + A_VB * ACT);
                float* ko = kp->out + O_KP + (size_t)li * MP * DM; float* vo = kp->out + O_VP + (size_t)li * MP * DM;
                float* kso = kp->out + O_KS + (size_t)li * MS * DM; float* vso = kp->out + O_VS + (size_t)li * MS * DM;
                int ct_ = threadIdx.x, cb_ = blockIdx.x, cg_ = gridDim.x; asm volatile("" : "+v"(ct_), "+s"(cb_), "+s"(cg_));
                for (size_t i = (size_t)cb_ * 512 + ct_; i < (size_t)MT * DM / 8; i += (size_t)cg_ * 512) {
                    const u32x4 a = *(const u32x4*)(kb + 4 * i), c4 = *(const u32x4*)(vb + 4 * i);
                    const size_t e = 8 * i;
                    float* kd = e < (size_t)MP * DM ? ko + e : kso + (e - (size_t)MP * DM);
                    float* vd = e < (size_t)MP * DM ? vo + e : vso + (e - (size_t)MP * DM);
                    *(f32x4*)kd = (f32x4){bf2f(a.x & 0xffffu), bf2f(a.x >> 16), bf2f(a.y & 0xffffu), bf2f(a.y >> 16)}; *(f32x4*)(kd + 4) = (f32x4){bf2f(a.z & 0xffffu), bf2f(a.z >> 16), bf2f(a.w & 0xffffu), bf2f(a.w >> 16)};
#ifdef CONVERT_K_ONLY
                    if (li == 0)
#endif
                    { *(f32x4*)vd = (f32x4){bf2f(c4.x & 0xffffu), bf2f(c4.x >> 16), bf2f(c4.y & 0xffffu), bf2f(c4.y >> 16)}; *(f32x4*)(vd + 4) = (f32x4){bf2f(c4.z & 0xffffu), bf2f(c4.z >> 16), bf2f(c4.w & 0xffffu), bf2f(c4.w >> 16)}; }
                }
            }
#ifdef P2L1_CONVERT_ONLY
            if (li == 0) {
#else
            {
#endif
            const int per = (1024 + G - 1) / G;
            for (int rep = 0; rep < ATT_REPS; ++rep)
            for (int it = vcu * per; it < (vcu + 1) * per && it < 1024; ++it) {
                const int bh = it >> 4, j = it & 15;
#ifndef SKIP_PA
                attn_unit<false>(lds, A, bh >> 3, bh & 7, j);
                attn_unit<false>(lds, A, bh >> 3, bh & 7, 31 - j);
#endif
            }
            const bool split = (G >= 256);
            for (int lrep = 0; lrep < LIGHT_REPS; ++lrep)
            for (int it = split ? (vcu < 128 ? vcu : 128 + (vcu - 128)) : vcu; it < 128 + 1024 + 64; it += split ? (vcu < 128 ? 1 << 30 : (G - 128)) : G) {
                if (it < 128) {
#ifndef SKIP_SA
                    attn_unit<true>(lds, A, it >> 3, it & 7, 0);
#endif
                }
                else if (it < 1152) { const int sp = it - 128, ch = sp >> 2, g = sp & 3;
                    spatial_unit(lds, ch * 128, 128, g, act + A_AV * ACT, act + A_UZ * ACT, act + A_YA * ACT, avssq, (const bf16_t*)(kp->ws + WS_WSB) + (size_t)(li * 4 + g) * 128 * 128,
                                 kp->in[7] + (li * 4 + g) * 128, kp->in[8] + li * DM, nullptr); }
                else { const int sp = it - 1152, b = sp >> 2, g = sp & 3;
                    spatial_unit(lds, MP + b * DSEQ, 64, g, act + A_AV * ACT, act + A_UZ * ACT, act + A_YA * ACT, avssq, (const bf16_t*)(kp->ws + WS_WSB) + (size_t)(li * 4 + g) * 128 * 128,
                                 kp->in[7] + (li * 4 + g) * 128, kp->in[8] + li * DM, kp->out + O_MV + ((size_t)li * MS + (size_t)b * DSEQ) * DM); }
            }
            }
        }
        PH_END();
        if (PH_IN() && !SKIP_P3A) {
            KP_DECL();
            pg8::StaticOrder S; S.init(MT, DM, G, bx);
            { pg8::Gemm g{act + A_YA * ACT, (const bf16_t*)(kp->ws + WS_WPA) + (size_t)li * DM * DM, MT, DM, DM};
#ifdef SKIP_G2
              pg8::EpiGate<0> E{act + A_SGA * ACT, nullptr, act + A_AV * ACT};
#else
              pg8::EpiGate<0> E{act + A_SGA * ACT, nullptr, act + A_UZ * ACT};
#endif
              pg8::gemm_phase<pg8::EpiGate<0>, pg8::StaticOrder, true, true>(lds, g, S, E); }
#ifndef SKIP_G2
            { pg8::Gemm g{act + A_YB * ACT, (const bf16_t*)(kp->ws + WS_WPB) + (size_t)li * DM * DM, MT, DM, DM};
              pg8::EpiGate<1> E{act + A_SGB * ACT, act + A_UZ * ACT, act + A_AV * ACT};
              pg8::gemm_phase<pg8::EpiGate<1>, pg8::StaticOrder, true, true>(lds, g, S, E); }
#endif
        }
        PH_END();
        if (PH_IN() && !SKIP_P3B) {
            KP_DECL();
            pg8::StaticOrder S; S.init(MT, DM, G, bx);
            pg8::Gemm g{act + A_AV * ACT, (const bf16_t*)(kp->ws + WS_WOUT) + (size_t)li * DM * DM, MT, DM, DM};
            pg8::EpiRes E{li == 0 ? kp->in[0] : X1, li == 0 ? kp->in[1] : X1 + (size_t)MP * DM, X1, (bf16_t*)(kp->ws + WS_XB1), (float*)(kp->ws + WS_PART) + (size_t)MT * 16, li == 0 ? 1 : 0};
            pg8::gemm_phase<pg8::EpiRes, pg8::StaticOrder, true, true>(lds, g, S, E);
        }
        PH_END();
    }
#ifdef DUMP_OFF
    {
        __builtin_amdgcn_fence(__ATOMIC_RELEASE, "agent"); asm volatile("s_waitcnt vmcnt(0) lgkmcnt(0)" ::: "memory"); grid.sync(); __builtin_amdgcn_fence(__ATOMIC_ACQUIRE, "agent"); asm volatile("s_waitcnt vmcnt(0) lgkmcnt(0)" ::: "memory");
        KP_DECL();
        const unsigned* srcb = (const unsigned*)(kp->ws + (size_t)(DUMP_OFF));
#ifdef DUMP_WIDE
        {
            float* ko = kp->out + O_KP + (size_t)MP * DM; float* kso = kp->out + O_KS + (size_t)MS * DM;
            for (size_t i = (size_t)bx * 512 + threadIdx.x; i < (size_t)MT * DM / 8; i += (size_t)G * 512) {
                const u32x4 a = *(const u32x4*)(srcb + 4 * i);
                const size_t e = 8 * i;
                float* kd = e < (size_t)MP * DM ? ko + e : kso + (e - (size_t)MP * DM);
                *(f32x4*)kd = (f32x4){bf2f(a.x & 0xffffu), bf2f(a.x >> 16), bf2f(a.y & 0xffffu), bf2f(a.y >> 16)}; *(f32x4*)(kd + 4) = (f32x4){bf2f(a.z & 0xffffu), bf2f(a.z >> 16), bf2f(a.w & 0xffffu), bf2f(a.w >> 16)};
            }
        }
#else
        for (size_t i = (size_t)bx * 512 + threadIdx.x; i < (size_t)MT * DM / 2; i += (size_t)G * 512) {
#ifdef DUMP_F32
            if (i < (size_t)DUMP_F32) kp->out[O_YP + i] = ((const float*)srcb)[i];
#else
            const unsigned v = srcb[i];
            if (i < (size_t)MP * DM / 2) { kp->out[O_KP + (size_t)MP * DM + 2 * i] = bf2f(v & 0xffffu); kp->out[O_KP + (size_t)MP * DM + 2 * i + 1] = bf2f(v >> 16); }
            else { const size_t j = i - (size_t)MP * DM / 2; kp->out[O_KS + (size_t)MS * DM + 2 * j] = bf2f(v & 0xffffu); kp->out[O_KS + (size_t)MS * DM + 2 * j + 1] = bf2f(v >> 16); }
#endif
        }
#endif
    }
#endif
    if (PH_IN()) {
        KP_DECL();
        if (CONVERT_AT_END) {
            const unsigned* kb = (const unsigned*)(act + A_KB * ACT); const unsigned* vb = (const unsigned*)(act + A_VB * ACT);
            float* ko = kp->out + O_KP + (size_t)MP * DM; float* vo = kp->out + O_VP + (size_t)MP * DM;
            float* kso = kp->out + O_KS + (size_t)MS * DM; float* vso = kp->out + O_VS + (size_t)MS * DM;
            for (size_t i = (size_t)bx * 512 + threadIdx.x; i < (size_t)MT * DM / 8; i += (size_t)G * 512) {
                const u32x4 a = *(const u32x4*)(kb + 4 * i), c4 = *(const u32x4*)(vb + 4 * i);
                const size_t e = 8 * i;
                float* kd = e < (size_t)MP * DM ? ko + e : kso + (e - (size_t)MP * DM);
                float* vd = e < (size_t)MP * DM ? vo + e : vso + (e - (size_t)MP * DM);
                *(f32x4*)kd = (f32x4){bf2f(a.x & 0xffffu), bf2f(a.x >> 16), bf2f(a.y & 0xffffu), bf2f(a.y >> 16)}; *(f32x4*)(kd + 4) = (f32x4){bf2f(a.z & 0xffffu), bf2f(a.z >> 16), bf2f(a.w & 0xffffu), bf2f(a.w >> 16)};
                *(f32x4*)vd = (f32x4){bf2f(c4.x & 0xffffu), bf2f(c4.x >> 16), bf2f(c4.y & 0xffffu), bf2f(c4.y >> 16)}; *(f32x4*)(vd + 4) = (f32x4){bf2f(c4.z & 0xffffu), bf2f(c4.z >> 16), bf2f(c4.w & 0xffffu), bf2f(c4.w >> 16)};
            }
        }
        int tid_ = threadIdx.x; asm volatile("" : "+v"(tid_)); const int lane = tid_ & 63, wave = tid_ >> 6;
        const int gw = bx * 8 + wave, NGW = G * 8;
        const float* gf = kp->in[17];
        f32x4 gv[4];
#pragma unroll
        for (int j = 0; j < 4; ++j) gv[j] = *(const f32x4*)(gf + 256 * j + 4 * lane);
        for (int m = gw; m < MT; m += NGW) {
            const float* xr = X1 + (size_t)m * DM;
            f32x4 v[4]; float s = 0.f;
#pragma unroll
            for (int j = 0; j < 4; ++j) { v[j] = *(const f32x4*)(xr + 256 * j + 4 * lane); s += v[j][0] * v[j][0] + v[j][1] * v[j][1] + v[j][2] * v[j][2] + v[j][3] * v[j][3]; }
            s = wave_sum(s);
            const float ri = 1.0f / sqrtf(s * (1.f / 1024.f) + EPS);
            float* orow = m < MP ? kp->out + O_YP + (size_t)m * DM : kp->out + O_YS + (size_t)(m - MP) * DM;
#pragma unroll
            for (int j = 0; j < 4; ++j) *(f32x4*)(orow + 256 * j + 4 * lane) = v[j] * ri * gv[j];
        }
    }
}

#ifndef PH_HI
#define PH_HI 100
#endif
#ifndef N_LAUNCH_MODE
#define N_LAUNCH_MODE 1
#endif
extern "C" void kernel_launch(void* const* d_in, const int* in_sizes, int n_in, void* d_out, int out_size, void* d_ws, size_t ws_size, hipStream_t stream) {
    static int grid = 0;
    if (grid == 0) {
        if (n_in != 18 || ws_size < WS_END) { fprintf(stderr, "kernel_launch: unexpected n_in %d / ws %zu (need %zu)\n", n_in, ws_size, (size_t)WS_END); grid = -1; return; }
        int dev = 0, cus = 0, per_cu = 0;
        hipGetDevice(&dev); hipDeviceGetAttribute(&cus, hipDeviceAttributeMultiprocessorCount, dev);
        if (hipFuncSetAttribute((const void*)fwd_kernel, hipFuncAttributeMaxDynamicSharedMemorySize, LDS_BYTES) != hipSuccess) { fprintf(stderr, "kernel_launch: hipFuncSetAttribute failed\n"); grid = -1; return; }
        if (hipOccupancyMaxActiveBlocksPerMultiprocessor(&per_cu, (const void*)fwd_kernel, 512, LDS_BYTES) != hipSuccess || per_cu < 1) { fprintf(stderr, "kernel_launch: occupancy query says %d\n", per_cu); per_cu = 1; }
        (void)hipGetLastError();
        grid = cus * 1;
    }
    if (grid < 0) return;
    Params p{};
    for (int i = 0; i < 18; ++i) p.in[i] = (const float*)d_in[i];
    p.out = (float*)d_out; p.ws = (unsigned char*)d_ws;
#if N_LAUNCH_MODE == 1
    p.ph_lo = 0; p.ph_hi = PH_HI;
    void* args[] = {&p};
    hipError_t e = hipLaunchCooperativeKernel((const void*)fwd_kernel, dim3(grid), dim3(512), args, LDS_BYTES, stream);
    if (e != hipSuccess) fprintf(stderr, "cooperative launch failed: %s (grid %d)\n", hipGetErrorString(e), grid);
#else
    for (int ph = 0; ph < 10 && ph < PH_HI; ++ph) { p.ph_lo = ph; p.ph_hi = ph + 1; hipLaunchKernelGGL(fwd_kernel, dim3(grid), dim3(512), LDS_BYTES, stream, p); }
#endif
}
```

```cpp
#include <hip/hip_runtime.h>
#include <hip/hip_cooperative_groups.h>
#include <cstdio>
#include <cstdint>
namespace cg = cooperative_groups;
namespace pg8 {
#define PG8_LAS __attribute__((address_space(3)))
typedef unsigned short bf16_t;
typedef short bf16x8 __attribute__((ext_vector_type(8)));
typedef float f32x4 __attribute__((ext_vector_type(4)));
typedef unsigned u32x4 __attribute__((ext_vector_type(4)));
constexpr int BM = 256, BK = 64, HALF = 128, HTB = HALF * BK * 2  , STAGE_BYTES = 8 * HTB, NXCD = 8, WGM = 8;

__host__ __device__ __forceinline__ int lds_byte(int r, int c) { const int st = (r >> 4) * 2 + (c >> 5), rr = r & 15, cc = c & 31, ob = rr * 64 + cc * 2; return st * 1024 + (ob ^ (((ob >> 9) & 1) << 5)); }
__host__ __device__ __forceinline__ void stage_rc(int b, int& R, int& C) { const int st = b / 1024, sb = b % 1024, swz = sb ^ (((sb >> 9) & 1) << 5); R = (st >> 1) * 16 + swz / 64; C = (st & 1) * 32 + (swz % 64) / 2; }
__host__ __device__ __forceinline__ int perm32(int rho) { const int n = rho >> 4, i = rho & 15; return 8 * (i >> 2) + 4 * n + (i & 3); }

struct Unit { int pm, pn; };
struct Gemm { const bf16_t* A; const bf16_t* Bt; int M, N, K; };

struct StaticOrder {
    int nM, nN, nwg, G, c;
    __host__ __device__ void init(int M, int N, int G_, int c_) { nM = M / BM; nN = N / BM; nwg = nM * nN; G = G_; c = c_; }
    __host__ __device__ bool next(int i, Unit& u) const {
        const long L = (long)i * G + c; if (L >= nwg) return false;
        int wgid = (int)L; { const int q = nwg / NXCD, r = nwg % NXCD, xcd = wgid % NXCD, off = wgid / NXCD; wgid = (xcd < r ? xcd * (q + 1) : r * (q + 1) + (xcd - r) * q) + off; }
        const int nig = WGM * nN, gid = wgid / nig, fm = gid * WGM, gsz = (nM - fm) < WGM ? (nM - fm) : WGM;
        u.pm = fm + ((wgid % nig) % gsz); u.pn = (wgid % nig) / gsz; return true;
    }
    __device__ __forceinline__ void a_ready(const Unit&) const {}
    __device__ __forceinline__ void done(const Unit&) const {}
};

typedef float f32x2 __attribute__((ext_vector_type(2)));
typedef float f32x2cv __attribute__((ext_vector_type(2))); typedef __bf16 bf16x2cv __attribute__((ext_vector_type(2)));
__device__ __forceinline__ unsigned cvt_pk_bf16(float lo, float hi) { const f32x2cv v = {lo, hi}; const bf16x2cv b = __builtin_convertvector(v, bf16x2cv); return __builtin_bit_cast(unsigned, b); }

#ifndef EPI_DRAIN_N
#define EPI_DRAIN_N 8
#endif
#define PG8_STR2(x) #x
#define PG8_STR(x) PG8_STR2(x)
#define EPI_DRAIN() asm volatile("s_waitcnt vmcnt(0)" ::: "memory")
template <class Epi, class Sched, bool ALIGN_EPI = false, bool SP2 = false>
__device__ __forceinline__ void gemm_phase(PG8_LAS unsigned char* lds, const Gemm g, const Sched& S, const Epi& E) {
    int tid_ = threadIdx.x; asm volatile("" : "+v"(tid_)); const int tid = tid_, wid = __builtin_amdgcn_readfirstlane(tid >> 6), lane = tid & 63, wr = wid >> 2, wc = wid & 3, fr = lane & 15, fq = lane >> 4;
    const int K = g.K, nt = K / BK;
    unsigned voffA[2], voffB[2];
#pragma unroll
    for (int i = 0; i < 2; ++i) { int R, C; stage_rc(tid * 16 + i * 8192, R, C); const int Rb = Epi::PERM ? ((R & ~31) + perm32(R & 31)) : R;
        voffA[i] = (unsigned)(R * K + C) * 2u; voffB[i] = (unsigned)(Rb * K + C) * 2u; }
    const size_t kstep = (size_t)(BK * 2);
    const size_t hstep = (size_t)HALF * K * 2;
    const size_t tstep = 2 * hstep;
    const unsigned ldsw = (unsigned)wid * 1024u;
    const int aoff = lds_byte(wr * 64 + fr, fq * 8), boff = lds_byte(wc * 32 + fr, fq * 8);
#define PG8_SA(b, h) (((b) * 2 + (h)) * HTB)
#define PG8_SB(b, h) ((4 + (b) * 2 + (h)) * HTB)
#define PG8_STAGE(bufoff, gbase, voff) do { _Pragma("unroll") for (int _i = 0; _i < 2; ++_i) \
        __builtin_amdgcn_global_load_lds((const unsigned*)((const char*)(gbase) + (voff)[_i]), (PG8_LAS unsigned*)(lds + (bufoff) + ldsw + _i * 8192), 16, 0, 0); } while (0)
#define PG8_LDA(dst, b, h) do { _Pragma("unroll") for (int m = 0; m < 4; ++m) _Pragma("unroll") for (int k = 0; k < 2; ++k) dst[m][k] = *(const PG8_LAS bf16x8*)(lds + PG8_SA(b, h) + aoff + m * 2048 + k * 1024); } while (0)
#define PG8_LDB(dst, b, h) do { _Pragma("unroll") for (int n = 0; n < 2; ++n) _Pragma("unroll") for (int k = 0; k < 2; ++k) dst[n][k] = *(const PG8_LAS bf16x8*)(lds + PG8_SB(b, h) + boff + n * 2048 + k * 1024); } while (0)
#define PG8_MMA(ai, bj, At, Bt) do { __builtin_amdgcn_s_setprio(1); _Pragma("unroll") for (int m = 0; m < 4; ++m) _Pragma("unroll") for (int n = 0; n < 2; ++n) _Pragma("unroll") for (int k = 0; k < 2; ++k) \
        acc[ai][bj][m][n] = __builtin_amdgcn_mfma_f32_16x16x32_bf16(Bt[n][k], At[m][k], acc[ai][bj][m][n], 0, 0, 0); __builtin_amdgcn_s_setprio(0); } while (0)
#define PG8_WAIT_V(n) asm volatile("s_waitcnt vmcnt(" #n ")" ::: "memory")
#define PG8_WAIT_L(n) asm volatile("s_waitcnt lgkmcnt(" #n ")" ::: "memory")
#define PG8_BAR __builtin_amdgcn_s_barrier()
#define PG8_SCHED __builtin_amdgcn_sched_barrier(0)
    Unit cur, nxt; int ui = 0;
    if (!S.next(0, cur)) return;
    f32x4 acc[2][2][4][2];
#pragma unroll
    for (int a = 0; a < 2; ++a)
#pragma unroll
        for (int b = 0; b < 2; ++b)
#pragma unroll
            for (int m = 0; m < 4; ++m)
#pragma unroll
                for (int n = 0; n < 2; ++n) acc[a][b][m][n] = (f32x4){0.f, 0.f, 0.f, 0.f};
    bf16x8 At[4][2], B0[2][2], B1[2][2];
    const char* cA = (const char*)g.A + (size_t)cur.pm * tstep; const char* cB = (const char*)g.Bt + (size_t)cur.pn * tstep;
    S.a_ready(cur);
    if constexpr (SP2) {
        PG8_STAGE(PG8_SB(0, 0), cB, voffB); PG8_STAGE(PG8_SB(0, 1), cB + hstep, voffB); PG8_STAGE(PG8_SA(0, 0), cA, voffA); PG8_STAGE(PG8_SA(0, 1), cA + hstep, voffA);
        if (wr == 1) PG8_BAR;
        PG8_WAIT_V(2); PG8_BAR;
        PG8_STAGE(PG8_SB(1, 0), cB + kstep, voffB); PG8_STAGE(PG8_SA(1, 0), cA + kstep, voffA); PG8_STAGE(PG8_SB(1, 1), cB + hstep + kstep, voffB);
        PG8_WAIT_V(6); PG8_BAR;
    } else {
        PG8_STAGE(PG8_SB(0, 0), cB, voffB); PG8_STAGE(PG8_SA(0, 0), cA, voffA); PG8_STAGE(PG8_SB(0, 1), cB + hstep, voffB); PG8_STAGE(PG8_SA(0, 1), cA + hstep, voffA);
        if (wr == 1) PG8_BAR;
        PG8_WAIT_V(4); PG8_BAR;
        PG8_STAGE(PG8_SB(1, 0), cB + kstep, voffB); PG8_STAGE(PG8_SA(1, 0), cA + kstep, voffA); PG8_STAGE(PG8_SB(1, 1), cB + hstep + kstep, voffB);
        PG8_WAIT_V(6); PG8_BAR;
    }
    for (;;) {
        const bool has_next = S.next(ui + 1, nxt);
        const char* nA = has_next ? (const char*)g.A + (size_t)nxt.pm * tstep : cA; const char* nB = has_next ? (const char*)g.Bt + (size_t)nxt.pn * tstep : cB;
        for (int t = 0; t < nt; t += 2) {
            const bool last = (t == nt - 2);
            const char* a1 = cA + (size_t)(t + 1) * kstep;
            const char* a2 = last ? nA : cA + (size_t)(t + 2) * kstep; const char* b2 = last ? nB : cB + (size_t)(t + 2) * kstep;
            const char* a3 = a2 + kstep; const char* b3 = b2 + kstep;
            if (last && has_next) S.a_ready(nxt);
            if constexpr (SP2) {
            PG8_LDB(B0, 0, 0); PG8_LDB(B1, 0, 1); PG8_SCHED; PG8_LDA(At, 0, 0); PG8_STAGE(PG8_SA(1, 1), a1 + hstep, voffA);
            PG8_WAIT_V(8); PG8_WAIT_L(0); PG8_BAR; PG8_MMA(0, 0, At, B0); PG8_MMA(0, 1, At, B1); PG8_BAR; PG8_SCHED;
            PG8_LDA(At, 0, 1); PG8_STAGE(PG8_SB(0, 0), b2, voffB); PG8_STAGE(PG8_SB(0, 1), b2 + hstep, voffB); PG8_STAGE(PG8_SA(0, 0), a2, voffA);
            PG8_WAIT_V(8); PG8_WAIT_L(0); PG8_BAR; PG8_MMA(1, 0, At, B0); PG8_MMA(1, 1, At, B1); PG8_BAR; PG8_SCHED;
            PG8_LDB(B0, 1, 0); PG8_LDB(B1, 1, 1); PG8_SCHED; PG8_LDA(At, 1, 0); PG8_STAGE(PG8_SA(0, 1), a2 + hstep, voffA);
            PG8_WAIT_V(8); PG8_WAIT_L(0); PG8_BAR; PG8_MMA(0, 0, At, B0); PG8_MMA(0, 1, At, B1); PG8_BAR; PG8_SCHED;
            PG8_LDA(At, 1, 1); PG8_STAGE(PG8_SB(1, 0), b3, voffB); PG8_STAGE(PG8_SB(1, 1), b3 + hstep, voffB); PG8_STAGE(PG8_SA(1, 0), a3, voffA);
            PG8_WAIT_V(8); PG8_WAIT_L(0); PG8_BAR; PG8_MMA(1, 0, At, B0); PG8_MMA(1, 1, At, B1); PG8_BAR; PG8_SCHED;
            } else {
            PG8_LDB(B0, 0, 0); PG8_SCHED; PG8_LDA(At, 0, 0); PG8_STAGE(PG8_SA(1, 1), a1 + hstep, voffA);
            PG8_WAIT_L(8); PG8_BAR; PG8_WAIT_L(0); PG8_MMA(0, 0, At, B0); PG8_BAR; PG8_SCHED;
            PG8_LDB(B1, 0, 1); PG8_STAGE(PG8_SB(0, 0), b2, voffB);
            PG8_BAR; PG8_WAIT_L(0); PG8_MMA(0, 1, At, B1); PG8_BAR;
            PG8_LDA(At, 0, 1); PG8_STAGE(PG8_SA(0, 0), a2, voffA);
            PG8_BAR; PG8_WAIT_L(0); PG8_MMA(1, 0, At, B0); PG8_BAR; PG8_SCHED;
            PG8_STAGE(PG8_SB(0, 1), b2 + hstep, voffB);
            PG8_WAIT_V(6); PG8_BAR; PG8_MMA(1, 1, At, B1); PG8_BAR;
            PG8_LDB(B0, 1, 0); PG8_SCHED; PG8_LDA(At, 1, 0); PG8_STAGE(PG8_SA(0, 1), a2 + hstep, voffA);
            PG8_WAIT_L(8); PG8_BAR; PG8_WAIT_L(0); PG8_MMA(0, 0, At, B0); PG8_BAR; PG8_SCHED;
            PG8_LDB(B1, 1, 1); PG8_STAGE(PG8_SB(1, 0), b3, voffB);
            PG8_BAR; PG8_WAIT_L(0); PG8_MMA(0, 1, At, B1); PG8_BAR;
            PG8_LDA(At, 1, 1); PG8_STAGE(PG8_SA(1, 0), a3, voffA);
            PG8_BAR; PG8_WAIT_L(0); PG8_MMA(1, 0, At, B0); PG8_BAR; PG8_SCHED;
            PG8_STAGE(PG8_SB(1, 1), b3 + hstep, voffB);
            PG8_WAIT_V(6); PG8_BAR; PG8_MMA(1, 1, At, B1); PG8_BAR;
            }
        }
        if constexpr (ALIGN_EPI) { if (wr == 0) PG8_BAR; }
        if constexpr (!Epi::AFTER_DRAIN) { E(acc, cur, wr, wc, fr, fq); S.done(cur); }
        if (!has_next) break;
#pragma unroll
        for (int a = 0; a < 2; ++a)
#pragma unroll
            for (int b = 0; b < 2; ++b)
#pragma unroll
                for (int m = 0; m < 4; ++m)
#pragma unroll
                    for (int n = 0; n < 2; ++n) acc[a][b][m][n] = (f32x4){0.f, 0.f, 0.f, 0.f};
        cur = nxt; cA = nA; cB = nB; ++ui;
        if constexpr (ALIGN_EPI) { if (wr == 1) PG8_BAR; }
    }
    PG8_WAIT_V(0);
    if constexpr (!ALIGN_EPI) { if (wr == 0) PG8_BAR; }
    PG8_BAR;
    if constexpr (Epi::AFTER_DRAIN) { E.fused(acc, cur, wr, wc, fr, fq, lds, wid, lane); S.done(cur); }
#undef PG8_SA
#undef PG8_SB
#undef PG8_STAGE
#undef PG8_LDA
#undef PG8_LDB
#undef PG8_MMA
#undef PG8_WAIT_V
#undef PG8_WAIT_L
#undef PG8_BAR
#undef PG8_SCHED
}
}
#define LAS __attribute__((address_space(3)))
typedef unsigned short bf16_t;
typedef short bf16x8 __attribute__((ext_vector_type(8)));
typedef short s16x4 __attribute__((ext_vector_type(4)));
typedef float f32x4 __attribute__((ext_vector_type(4)));
typedef float f32x16 __attribute__((ext_vector_type(16)));
typedef unsigned u32x4 __attribute__((ext_vector_type(4)));
typedef unsigned u32x2 __attribute__((ext_vector_type(2)));

constexpr int DM = 1024, NBATCH = 8, SEQ = 4096, DBATCH = 16, DSEQ = 64, PAST = 2048;
constexpr int MP = NBATCH * SEQ, MS = DBATCH * DSEQ, MT = MP + MS;
constexpr int DIN = 9216;
constexpr float EPS = 1e-6f;
constexpr float QSCALE = 0.125f * 1.4426950408889634f;
constexpr size_t ACT = (size_t)MT * DM;
constexpr size_t O_YP = 0, O_YS = (size_t)MP * DM, O_KP = O_YS + (size_t)MS * DM, O_VP = O_KP + 2 * (size_t)MP * DM,
                 O_KS = O_VP + 2 * (size_t)MP * DM, O_VS = O_KS + 2 * (size_t)MS * DM, O_MV = O_VS + 2 * (size_t)MS * DM;
constexpr size_t MiB = 1u << 20;
constexpr size_t WS_CTL = 0;
constexpr size_t WS_WIN = 1 * MiB, WS_WPA = 37 * MiB, WS_WPB = 41 * MiB, WS_WOUT = 45 * MiB, WS_WSB = 49 * MiB;
constexpr size_t WS_XB = 50 * MiB, WS_X1 = 116 * MiB, WS_ACT = 248 * MiB;
constexpr size_t ACT_BYTES = 66 * MiB;
constexpr size_t WS_PART = WS_ACT + 10 * ACT_BYTES;
constexpr size_t WS_XB1 = WS_PART + 16 * MiB;
constexpr size_t WS_END = WS_XB1 + 66 * MiB;
static_assert(ACT * 2 == ACT_BYTES, "act size");
enum { A_UZ = 0, A_AV, A_QB, A_KB, A_VB, A_BZ, A_SGA, A_SGB, A_YA, A_YB };
constexpr int LDS_BYTES = 135168;

__device__ __forceinline__ float bf2f(unsigned v) { return __uint_as_float(v << 16); }
__device__ __forceinline__ unsigned f2bf(float f) { unsigned u = __float_as_uint(f); return (u + 0x7fffu + ((u >> 16) & 1u)) >> 16; }
__device__ __forceinline__ unsigned pk2(float lo, float hi) { return pg8::cvt_pk_bf16(lo, hi); }
__device__ __forceinline__ float fexp2(float x) { return __builtin_amdgcn_exp2f(x); }
__device__ __forceinline__ float frcp(float x) { return __builtin_amdgcn_rcpf(x); }
__device__ __forceinline__ float sigm(float x) { return frcp(1.f + fexp2(-1.4426950409f * x)); }
__device__ __forceinline__ float silu(float x) { return x * sigm(x); }
__device__ __forceinline__ float gelu_t(float x) { const float u = x + 0.044715f * x * x * x; return x * frcp(1.f + fexp2(-2.3022082f * u)); }
__device__ __forceinline__ float gelu_silu(float u, float z) { const float w = u + 0.044715f * u * u * u; const float d = (1.f + fexp2(-2.3022082f * w)) * (1.f + fexp2(-1.4426950409f * z)); return (u * z) * frcp(d); }
__device__ __forceinline__ float wave_sum(float v) {
#pragma unroll
    for (int o = 1; o < 64; o <<= 1) v += __shfl_xor(v, o);
    return v;
}

namespace pg8 {
struct EpiIn {
    static constexpr bool PERM = true, AFTER_DRAIN = false;
    const float* xpart; float* avpart; bf16_t* act; float *kp, *vp, *ks, *vs;
    __device__ __forceinline__ float rinv_of(int row, int fq) const { const f32x4 q = *(const f32x4*)(xpart + ((size_t)fq * MT + row) * 4);     float s = (q[0] + q[1]) + (q[2] + q[3]); s += __shfl_xor(s, 16); s += __shfl_xor(s, 32); return __builtin_amdgcn_rsqf(s * (1.f / 1024.f) + EPS); }
    template <int SEC> __device__ __forceinline__ void body(const f32x4 (&acc)[2][2][4][2], const Unit& u, int rowb, int cb, int wc, int fq) const {
        bf16_t* dst = act + (size_t)(SEC + 1) * ACT;
#pragma unroll
        for (int ai = 0; ai < 2; ++ai)
#pragma unroll
            for (int m = 0; m < 4; ++m) {
                const int row = rowb + ai * HALF + m * 16;
                const float r = rinv_of(row, fq);
                float ssq = 0.f;
#pragma unroll
                for (int bj = 0; bj < 2; ++bj) {
                    f32x4 v0 = acc[ai][bj][m][0] * r, v1 = acc[ai][bj][m][1] * r;
                    const int col = cb + bj * HALF;
                    if (SEC == 0) {
#pragma unroll
                        for (int j = 0; j < 4; ++j) { v0[j] = gelu_t(v0[j]); v1[j] = gelu_t(v1[j]); ssq += v0[j] * v0[j] + v1[j] * v1[j]; }
                    } else if (SEC == 1) { v0 = v0 * QSCALE; v1 = v1 * QSCALE; }
                    else if (SEC == 2 || SEC == 3) {
                        float* o = (SEC == 2) ? (row < MP ? kp + (size_t)row * DM : ks + (size_t)(row - MP) * DM) : (row < MP ? vp + (size_t)row * DM : vs + (size_t)(row - MP) * DM);
                        *(f32x4*)(o + col) = v0; *(f32x4*)(o + col + 4) = v1;
                    } else if (SEC == 4) {
#pragma unroll
                        for (int j = 0; j < 4; ++j) { v0[j] = silu(v0[j]); v1[j] = silu(v1[j]); }
                    } else {
#ifndef RAW_GATE
#pragma unroll
                        for (int j = 0; j < 4; ++j) { v0[j] = sigm(v0[j]); v1[j] = sigm(v1[j]); }
#endif
                    }
                    u32x4 w; w.x = cvt_pk_bf16(v0[0], v0[1]); w.y = cvt_pk_bf16(v0[2], v0[3]); w.z = cvt_pk_bf16(v1[0], v1[1]); w.w = cvt_pk_bf16(v1[2], v1[3]);
                    *(u32x4*)(dst + (size_t)row * DM + col) = w;
                }
                if (SEC == 0) { ssq += __shfl_xor(ssq, 16); ssq += __shfl_xor(ssq, 32); if (fq == 0) avpart[((size_t)((u.pn - 8) & 3) * MT + row) * 4 + wc] = ssq; }
            }
    }
    __device__ __forceinline__ void operator()(const f32x4 (&acc)[2][2][4][2], const Unit& u, int wr, int wc, int fr, int fq) const {
        const int pn = u.pn, rowb = u.pm * BM + wr * 64 + fr, cl = wc * 32 + 8 * fq;
        if (pn < 8) {
#pragma unroll
            for (int ai = 0; ai < 2; ++ai)
#pragma unroll
                for (int m = 0; m < 4; ++m) {
                    const int row = rowb + ai * HALF + m * 16;
                    const float r = rinv_of(row, fq);
                    const f32x4 u0 = acc[ai][0][m][0] * r, u1 = acc[ai][0][m][1] * r, z0 = acc[ai][1][m][0] * r, z1 = acc[ai][1][m][1] * r;
                    f32x4 o0, o1;
#pragma unroll
                    for (int j = 0; j < 4; ++j) { o0[j] = gelu_silu(u0[j], z0[j]); o1[j] = gelu_silu(u1[j], z1[j]); }
                    u32x4 w; w.x = cvt_pk_bf16(o0[0], o0[1]); w.y = cvt_pk_bf16(o0[2], o0[3]); w.z = cvt_pk_bf16(o1[0], o1[1]); w.w = cvt_pk_bf16(o1[2], o1[3]);
                    *(u32x4*)(act + (size_t)row * DM + pn * HALF + cl) = w;
                }
        } else {
            const int sec = (pn - 8) >> 2, cb = ((pn - 8) & 3) * BM + cl;
            switch (sec) {
                case 0: body<0>(acc, u, rowb, cb, wc, fq); break;
                case 1: body<1>(acc, u, rowb, cb, wc, fq); break;
                case 2: body<2>(acc, u, rowb, cb, wc, fq); break;
                case 3: body<3>(acc, u, rowb, cb, wc, fq); break;
                case 4: body<4>(acc, u, rowb, cb, wc, fq); break;
                case 5: body<5>(acc, u, rowb, cb, wc, fq); break;
                default: body<6>(acc, u, rowb, cb, wc, fq); break;
            }
        }
    }
};
template <int MODE> struct EpiGate {
    static constexpr bool PERM = true, AFTER_DRAIN = false;
    const bf16_t* gate; const bf16_t* prev; bf16_t* out;
    __device__ __forceinline__ void operator()(const f32x4 (&acc)[2][2][4][2], const Unit& u, int wr, int wc, int fr, int fq) const {
        const int rowb = u.pm * BM + wr * 64 + fr, cb = u.pn * BM + wc * 32 + 8 * fq;
#pragma unroll
        for (int ai = 0; ai < 2; ++ai)
#pragma unroll
            for (int m = 0; m < 4; ++m) {
                const size_t ro = (size_t)(rowb + ai * HALF + m * 16) * DM;
#pragma unroll
                for (int bj = 0; bj < 2; ++bj) {
                    const size_t off = ro + cb + bj * HALF;
#ifdef NO_GATE
                    const u32x4 g = (u32x4){0x3f803f80u, 0x3f803f80u, 0x3f803f80u, 0x3f803f80u};
#else
                    const u32x4 g = *(const u32x4*)(gate + off);
#endif
                    f32x4 v0 = acc[ai][bj][m][0], v1 = acc[ai][bj][m][1];
                    v0[0] *= bf2f(g.x & 0xffffu); v0[1] *= bf2f(g.x >> 16); v0[2] *= bf2f(g.y & 0xffffu); v0[3] *= bf2f(g.y >> 16);
                    v1[0] *= bf2f(g.z & 0xffffu); v1[1] *= bf2f(g.z >> 16); v1[2] *= bf2f(g.w & 0xffffu); v1[3] *= bf2f(g.w >> 16);
                    if (MODE == 1) { const u32x4 q = *(const u32x4*)(prev + off);
                        v0[0] += bf2f(q.x & 0xffffu); v0[1] += bf2f(q.x >> 16); v0[2] += bf2f(q.y & 0xffffu); v0[3] += bf2f(q.y >> 16);
                        v1[0] += bf2f(q.z & 0xffffu); v1[1] += bf2f(q.z >> 16); v1[2] += bf2f(q.w & 0xffffu); v1[3] += bf2f(q.w >> 16); }
                    u32x4 w; w.x = cvt_pk_bf16(v0[0], v0[1]); w.y = cvt_pk_bf16(v0[2], v0[3]); w.z = cvt_pk_bf16(v1[0], v1[1]); w.w = cvt_pk_bf16(v1[2], v1[3]);
                    *(u32x4*)(out + off) = w;
                }
                asm volatile("" ::: "memory");
            }
    }
};
struct EpiRes {
    static constexpr bool PERM = true, AFTER_DRAIN = false;
    const float* xp; const float* xs;
    float* x1; bf16_t* xb; float* ssq; int next;
    __device__ __forceinline__ void operator()(const f32x4 (&acc)[2][2][4][2], const Unit& u, int wr, int wc, int fr, int fq) const {
        const int rowb = u.pm * BM + wr * 64 + fr, cb = u.pn * BM + wc * 32 + 8 * fq;
#pragma unroll
        for (int ai = 0; ai < 2; ++ai)
#pragma unroll
            for (int m = 0; m < 4; ++m) {
                const int row = rowb + ai * HALF + m * 16;
                const float* src = row < MP ? xp + (size_t)row * DM : xs + (size_t)(row - MP) * DM;
                float s = 0.f;
#pragma unroll
                for (int bj = 0; bj < 2; ++bj) {
                    const int col = cb + bj * HALF;
                    const f32x4 v0 = acc[ai][bj][m][0] + *(const f32x4*)(src + col), v1 = acc[ai][bj][m][1] + *(const f32x4*)(src + col + 4);
                    *(f32x4*)(x1 + (size_t)row * DM + col) = v0; *(f32x4*)(x1 + (size_t)row * DM + col + 4) = v1;
                    if (next) {
                        u32x4 w; w.x = cvt_pk_bf16(v0[0], v0[1]); w.y = cvt_pk_bf16(v0[2], v0[3]); w.z = cvt_pk_bf16(v1[0], v1[1]); w.w = cvt_pk_bf16(v1[2], v1[3]);
                        *(u32x4*)(xb + (size_t)row * DM + col) = w;
#pragma unroll
                        for (int j = 0; j < 4; ++j) s += v0[j] * v0[j] + v1[j] * v1[j];
                    }
                }
                if (next) { s += __shfl_xor(s, 16); s += __shfl_xor(s, 32); if (fq == 0) ssq[((size_t)u.pn * MT + row) * 4 + wc] = s; }
                asm volatile("" ::: "memory");
            }
    }
};
}
__device__ __forceinline__ void tr_item(const float* W, int N, int ncol0, int k0, const float* kscale, bf16_t* WTrow0, LAS float* scr, int lane) {
#pragma unroll
    for (int i = 0; i < 32; ++i) { const int kk = 2 * i + (lane >> 5); float v = W[(size_t)(k0 + kk) * N + ncol0 + (lane & 31)]; if (kscale) v *= kscale[k0 + kk]; scr[kk * 33 + (lane & 31)] = v; }
    asm volatile("s_waitcnt lgkmcnt(0)" ::: "memory");
    const int c = lane & 7;
#pragma unroll
    for (int j = 0; j < 4; ++j) { const int n = (lane >> 3) + 8 * j; const LAS float* s = scr + (8 * c) * 33 + n;
        u32x4 o; o.x = pk2(s[0 * 33], s[1 * 33]); o.y = pk2(s[2 * 33], s[3 * 33]); o.z = pk2(s[4 * 33], s[5 * 33]); o.w = pk2(s[6 * 33], s[7 * 33]);
        *(u32x4*)(WTrow0 + (size_t)n * DM + k0 + 8 * c) = o; }
    asm volatile("s_waitcnt lgkmcnt(0)" ::: "memory");
}
struct Params { const float* in[18]; float* out; unsigned char* ws; int ph_lo, ph_hi; };

typedef const __attribute__((address_space(4))) Params* KArgsP;
__device__ __forceinline__ void phase_prologue(KArgsP kp, LAS unsigned char* lds) {
    int tid_ = threadIdx.x; asm volatile("" : "+v"(tid_)); const int tid = tid_, lane = tid & 63, wave = tid >> 6, G = gridDim.x;
    const int gw = blockIdx.x * 8 + wave, NGW = G * 8;
    LAS float* scr = (LAS float*)(lds + wave * 8448);
    float* ctl = (float*)(kp->ws + WS_CTL);
    float* xpart = (float*)(kp->ws + WS_PART);
    constexpr int I_IN = 16 * 288, I_P = 16 * 32, I_L = I_IN + 3 * I_P;
    for (int it = gw; it < 2 * I_L; it += NGW) {
        const int li = it / I_L; int r = it % I_L;
        if (r < I_IN) {
            const int kb = r / 288, nb = r % 288, d0 = nb * 32;
            int src;
            if (d0 < 2048) { const int t = d0 >> 8, wi = d0 & 255; src = wi < 128 ? 128 * t + wi : 2048 + 128 * t + (wi - 128); }
            else if (d0 < 3072) src = d0 - 1024;
            else src = d0;
            tr_item(kp->in[5] + (size_t)li * DM * DIN, DIN, src, kb * 64, kp->in[4] + li * DM, (bf16_t*)(kp->ws + WS_WIN) + ((size_t)li * DIN + d0) * DM, scr, lane);
        } else {
            r -= I_IN; const int which = r / I_P; r %= I_P; const int kb = r / 32, nb = r % 32;
            const float* W = kp->in[14 + which] + (size_t)li * DM * DM;
            bf16_t* WT = (bf16_t*)(kp->ws + (which == 0 ? WS_WPA : which == 1 ? WS_WPB : WS_WOUT)) + ((size_t)li * DM + nb * 32) * DM;
            tr_item(W, DM, nb * 32, kb * 64, nullptr, WT, scr, lane);
        }
    }
    bf16_t* XB = (bf16_t*)(kp->ws + WS_XB);
    for (int m = gw; m < MT; m += NGW) {
        const float* xr = m < MP ? kp->in[0] + (size_t)m * DM : kp->in[1] + (size_t)(m - MP) * DM;
        f32x4 v[4]; float s = 0.f;
#pragma unroll
        for (int j = 0; j < 4; ++j) { v[j] = *(const f32x4*)(xr + 256 * j + 4 * lane); s += v[j][0] * v[j][0] + v[j][1] * v[j][1] + v[j][2] * v[j][2] + v[j][3] * v[j][3]; }
        s = wave_sum(s);
#pragma unroll
        for (int j = 0; j < 4; ++j) { u32x2 w; w.x = pk2(v[j][0], v[j][1]); w.y = pk2(v[j][2], v[j][3]); *(u32x2*)(XB + (size_t)m * DM + 256 * j + 4 * lane) = w; }
        if (lane < 16) xpart[((size_t)(lane >> 2) * MT + m) * 4 + (lane & 3)] = s * (1.f / 16.f);
    }
    const int gt = blockIdx.x * 512 + tid, NGT = G * 512;
    bf16_t* WSB = (bf16_t*)(kp->ws + WS_WSB);
    for (int i = gt; i < 2 * 4 * 128 * 128; i += NGT) { const int s = i & 127, t = (i >> 7) & 127; WSB[i] = (bf16_t)(s <= t ? f2bf(kp->in[6][i]) : 0u); }
    if (blockIdx.x == 0 && wave == 0) {
        for (int li = 0; li < 2; ++li) {
            const float d1 = wave_sum(kp->in[9][li * 64 + lane] * kp->in[10][li * 64 + lane]);
            const float d2 = wave_sum(kp->in[11][li * 64 + lane] * kp->in[12][li * 64 + lane]);
            const float lam_init = 0.8f - 0.6f * expf(-0.3f * (float)li);
            if (lane == 0) ctl[li] = expf(d1) - expf(d2) + lam_init;
        }
    }
}

constexpr int KP = 272, VP = 320, KIMG = 64 * KP, VIMG = 64 * VP;
constexpr int L_K0 = 0, L_V0 = 2 * KIMG, L_WSF = L_V0 + 2 * VIMG, L_ATT_END = L_WSF + 2048;
static_assert(L_ATT_END <= LDS_BYTES && 128 * 128 * 4 <= L_WSF, "attention LDS map");
__device__ __forceinline__ int crow(int i, int h) { return (i & 3) + 8 * (i >> 2) + 4 * h; }
typedef short v4i16_t __attribute__((ext_vector_type(4)));
__device__ __forceinline__ s16x4 trr(const LAS unsigned char* p) { return __builtin_bit_cast(s16x4, __builtin_amdgcn_ds_read_tr16_b64_v4i16((LAS v4i16_t*)p)); }
#define MFMA32(a, b, c) __builtin_amdgcn_mfma_f32_32x32x16_bf16((a), (b), (c), 0, 0, 0)

struct AttnArgs { const bf16_t *QB, *KB, *VB, *BZ; bf16_t* YB; const float *ck, *cv, *nks, *nvs; const float* ang; float lam, post; };

template <bool SAMPLE>
__device__ __forceinline__ void attn_unit(LAS unsigned char* lds, const AttnArgs& A, int b, int h, int qb) {
    constexpr int ND = SAMPLE ? 2 : 4;
    int tid_ = threadIdx.x; asm volatile("" : "+v"(tid_)); const int tid = tid_, lane = tid & 63, w = __builtin_amdgcn_readfirstlane(tid >> 6), r = lane & 31, hh = lane >> 5;
    const int map = w >> 2, wq = SAMPLE ? ((w >> 1) & 1) : (w & 3), dbase = SAMPLE ? (w & 1) * 2 : 0;
    const int NT = SAMPLE ? 33 : 2 * qb + 2;
    const int ntw = SAMPLE ? 33 : 2 * qb + 1 + (wq >> 1);
    const size_t qrow0 = SAMPLE ? (size_t)MP + (size_t)b * DSEQ : (size_t)b * SEQ + (size_t)qb * 128;
    bf16x8 qf[4];
    { const size_t qr = qrow0 + wq * 32 + r; const bf16_t* qp = A.QB + qr * DM + h * 128 + map * 64 + hh * 8;
#pragma unroll
      for (int ds = 0; ds < 4; ++ds) qf[ds] = *(const bf16x8*)(qp + ds * 16); }
    const int lr = tid >> 4, c16 = tid & 15;
    u32x4 kst[2], vst[2];
    f32x4 ksf[2][2], vsf[2][2];
    auto issue = [&](int t) {
        if (!SAMPLE) {
            const size_t base = ((size_t)b * SEQ + (size_t)t * 64 + lr) * DM + h * 128 + c16 * 8;
#pragma unroll
            for (int i = 0; i < 2; ++i) { kst[i] = *(const u32x4*)(A.KB + base + (size_t)i * 32 * DM); vst[i] = *(const u32x4*)(A.VB + base + (size_t)i * 32 * DM); }
        } else {
            const size_t off = (size_t)lr * DM + h * 128 + c16 * 8;
            if (t < 32) {
                const float* kb = A.ck + ((size_t)b * PAST + (size_t)t * 64) * DM;
                const float* vb = A.cv + ((size_t)b * PAST + (size_t)t * 64) * DM;
#pragma unroll
                for (int i = 0; i < 2; ++i) { ksf[i][0] = *(const f32x4*)(kb + off + (size_t)i * 32 * DM); ksf[i][1] = *(const f32x4*)(kb + off + (size_t)i * 32 * DM + 4);
                                              vsf[i][0] = *(const f32x4*)(vb + off + (size_t)i * 32 * DM); vsf[i][1] = *(const f32x4*)(vb + off + (size_t)i * 32 * DM + 4); }
            } else {
                const bf16_t* kb = A.KB + ((size_t)MP + (size_t)b * DSEQ) * DM;
                const bf16_t* vb = A.VB + ((size_t)MP + (size_t)b * DSEQ) * DM;
#pragma unroll
                for (int i = 0; i < 2; ++i) {
                    const u32x4 kr = *(const u32x4*)(kb + off + (size_t)i * 32 * DM), vr = *(const u32x4*)(vb + off + (size_t)i * 32 * DM);
                    ksf[i][0] = (f32x4){bf2f(kr.x & 0xffffu), bf2f(kr.x >> 16), bf2f(kr.y & 0xffffu), bf2f(kr.y >> 16)}; ksf[i][1] = (f32x4){bf2f(kr.z & 0xffffu), bf2f(kr.z >> 16), bf2f(kr.w & 0xffffu), bf2f(kr.w >> 16)};
                    vsf[i][0] = (f32x4){bf2f(vr.x & 0xffffu), bf2f(vr.x >> 16), bf2f(vr.y & 0xffffu), bf2f(vr.y >> 16)}; vsf[i][1] = (f32x4){bf2f(vr.z & 0xffffu), bf2f(vr.z >> 16), bf2f(vr.w & 0xffffu), bf2f(vr.w >> 16)};
                }
            }
        }
    };
    auto commit = [&](int buf) {
#pragma unroll
        for (int i = 0; i < 2; ++i) {
            u32x4 kw, vw;
            if (!SAMPLE) { kw = kst[i]; vw = vst[i]; }
            else { kw.x = pk2(ksf[i][0][0], ksf[i][0][1]); kw.y = pk2(ksf[i][0][2], ksf[i][0][3]); kw.z = pk2(ksf[i][1][0], ksf[i][1][1]); kw.w = pk2(ksf[i][1][2], ksf[i][1][3]);
                   vw.x = pk2(vsf[i][0][0], vsf[i][0][1]); vw.y = pk2(vsf[i][0][2], vsf[i][0][3]); vw.z = pk2(vsf[i][1][0], vsf[i][1][1]); vw.w = pk2(vsf[i][1][2], vsf[i][1][3]); }
            *(LAS u32x4*)(lds + L_K0 + buf * KIMG + (lr + 32 * i) * KP + c16 * 16) = kw;
            *(LAS u32x4*)(lds + L_V0 + buf * VIMG + (lr + 32 * i) * VP + c16 * 16) = vw;
        }
    };
    LAS float* wsf = (LAS float*)(lds + L_WSF) + w * 64;
    f32x16 o[ND];
#pragma unroll
    for (int d = 0; d < ND; ++d)
#pragma unroll
        for (int i = 0; i < 16; ++i) o[d][i] = 0.f;
    float mrun = 0.f, lrun = 0.f;
    f32x16 negm;
#pragma unroll
    for (int i = 0; i < 16; ++i) negm[i] = 0.f;
    const int q4 = (lane & 15) >> 2, pp = lane & 3, blk = (lane >> 4) & 1;
    const int koff = map * 128 + r * KP + hh * 16, voff = (4 * hh + q4) * VP + blk * 32 + pp * 8 + dbase * 64;

    issue(0); commit(0); __syncthreads();
    for (int t = 0; t < NT; ++t) {
        const int buf = t & 1;
        if (t + 1 < NT) issue(t + 1);
        if (t < ntw) {
            const LAS unsigned char* kb = lds + L_K0 + buf * KIMG + koff;
            f32x16 p0, p1;
#pragma unroll
            for (int ds = 0; ds < 4; ++ds) {
                const bf16x8 k0 = *(const LAS bf16x8*)(kb + ds * 32), k1 = *(const LAS bf16x8*)(kb + 32 * KP + ds * 32);
                if (ds == 0) { p0 = MFMA32(k0, qf[0], negm); p1 = MFMA32(k1, qf[0], negm); }
                else { p0 = MFMA32(k0, qf[ds], p0); p1 = MFMA32(k1, qf[ds], p1); }
            }
            float mx = fmaxf(p0[0], p1[0]);
#pragma unroll
            for (int i = 1; i < 16; ++i) mx = fmaxf(mx, fmaxf(p0[i], p1[i]));
            mx = fmaxf(mx, __shfl_xor(mx, 32));
            const bool first = (t == 0);
            if (first || __any(mx > 8.f)) {
                const float dl = first ? mx : fmaxf(mx, 0.f);
                const float al = first ? 1.f : fexp2(-dl);
                lrun *= al; mrun += dl;
#pragma unroll
                for (int i = 0; i < 16; ++i) { p0[i] -= dl; p1[i] -= dl; negm[i] = -mrun; }
                if (!first) {
                    if (hh == 0) wsf[r] = al;
                    asm volatile("s_waitcnt lgkmcnt(0)" ::: "memory");
#pragma unroll
                    for (int g = 0; g < 4; ++g) { const f32x4 a4 = *(const LAS f32x4*)(wsf + 8 * g + 4 * hh);
#pragma unroll
                        for (int d = 0; d < ND; ++d)
#pragma unroll
                            for (int j = 0; j < 4; ++j) o[d][4 * g + j] *= a4[j]; }
                }
            }
            float ls = 0.f;
#pragma unroll
            for (int i = 0; i < 16; ++i) { p0[i] = fexp2(p0[i]); p1[i] = fexp2(p1[i]); ls += p0[i] + p1[i]; }
            lrun += ls;
            bf16x8 pa[4];
#pragma unroll
            for (int s = 0; s < 4; ++s) {
                u32x4 pw;
                if (s < 2) { pw.x = pk2(p0[8 * s + 0], p0[8 * s + 1]); pw.y = pk2(p0[8 * s + 2], p0[8 * s + 3]); pw.z = pk2(p0[8 * s + 4], p0[8 * s + 5]); pw.w = pk2(p0[8 * s + 6], p0[8 * s + 7]); }
                else { const int s2 = s - 2; pw.x = pk2(p1[8 * s2 + 0], p1[8 * s2 + 1]); pw.y = pk2(p1[8 * s2 + 2], p1[8 * s2 + 3]); pw.z = pk2(p1[8 * s2 + 4], p1[8 * s2 + 5]); pw.w = pk2(p1[8 * s2 + 6], p1[8 * s2 + 7]); }
                pa[s] = __builtin_bit_cast(bf16x8, pw);
            }
            const LAS unsigned char* vb = lds + L_V0 + buf * VIMG + voff;
#pragma unroll
            for (int d = 0; d < ND; ++d) {
#pragma unroll
                for (int s = 0; s < 4; ++s) {
                    const s16x4 lo = trr(vb + s * 16 * VP + d * 64), hi = trr(vb + s * 16 * VP + 8 * VP + d * 64);
                    const bf16x8 vf = __builtin_shufflevector(lo, hi, 0, 1, 2, 3, 4, 5, 6, 7);
                    o[d] = MFMA32(pa[s], vf, o[d]);
                }
                if (d & 1) __builtin_amdgcn_sched_barrier(0);
            }
        }
        if (t + 1 < NT) commit(buf ^ 1);
        __syncthreads();
    }
    {
        lrun += __shfl_xor(lrun, 32);
        if (hh == 0) wsf[r] = frcp(lrun);
        asm volatile("s_waitcnt lgkmcnt(0)" ::: "memory");
#pragma unroll
        for (int g = 0; g < 4; ++g) { const f32x4 a4 = *(const LAS f32x4*)(wsf + 8 * g + 4 * hh);
#pragma unroll
            for (int d = 0; d < ND; ++d)
#pragma unroll
                for (int j = 0; j < 4; ++j) o[d][4 * g + j] *= a4[j]; }
    }
    LAS float* exch = (LAS float*)lds;
    LAS float* red = (LAS float*)(lds + 65536);
    if (map == 1) {
#pragma unroll
        for (int d = 0; d < ND; ++d)
#pragma unroll
            for (int i = 0; i < 16; ++i) exch[(wq * 32 + crow(i, hh)) * 128 + (dbase + d) * 32 + r] = o[d][i];
    }
    __syncthreads();
    float ss[16];
#pragma unroll
    for (int i = 0; i < 16; ++i) ss[i] = 0.f;
    if (map == 0) {
#pragma unroll
        for (int d = 0; d < ND; ++d)
#pragma unroll
            for (int i = 0; i < 16; ++i) { const float v = o[d][i] - A.lam * exch[(wq * 32 + crow(i, hh)) * 128 + (dbase + d) * 32 + r]; o[d][i] = v; ss[i] += v * v; }
#pragma unroll
        for (int i = 0; i < 16; ++i) {
#pragma unroll
            for (int off = 1; off < 32; off <<= 1) ss[i] += __shfl_xor(ss[i], off);
        }
        if (SAMPLE && r == 0) {
#pragma unroll
            for (int i = 0; i < 16; ++i) red[w * 32 + crow(i, hh)] = ss[i];
        }
    }
    if (SAMPLE) __syncthreads();
    if (map == 0) {
#pragma unroll
        for (int i = 0; i < 16; ++i) {
            if (SAMPLE) ss[i] += red[(w ^ 1) * 32 + crow(i, hh)];
            ss[i] = __builtin_amdgcn_rsqf(ss[i] * (1.f / 128.f) + EPS) * A.post;
        }
#pragma unroll
        for (int d = 0; d < ND; ++d) {
            const float gc = A.ang[(dbase + d) * 32 + r];
#pragma unroll
            for (int i = 0; i < 16; ++i) {
                const size_t idx = (qrow0 + wq * 32 + crow(i, hh)) * DM + h * 128 + (dbase + d) * 32 + r;
                A.YB[idx] = (bf16_t)f2bf(o[d][i] * ss[i] * gc * bf2f(A.BZ[idx]));
            }
        }
    }
    __syncthreads();
}

constexpr int XP = 576, L_RINV = 128 * XP;
__device__ __forceinline__ void spatial_unit(LAS unsigned char* lds, int row0, int nrows, int g, const bf16_t* AV, const bf16_t* UZ, bf16_t* YA,
                                             const float* avssq, const bf16_t* WsB, const float* bsg, const float* vng, float* mlpv) {
    int tid_ = threadIdx.x; asm volatile("" : "+v"(tid_)); const int tid = tid_, lane = tid & 63, w = __builtin_amdgcn_readfirstlane(tid >> 6), r = lane & 31, hh = lane >> 5;
    LAS float* rinv = (LAS float*)(lds + L_RINV);
    if (tid < nrows) { const float* q = avssq + (size_t)(row0 + tid) * 4; const f32x4 a = *(const f32x4*)q, b4 = *(const f32x4*)(q + (size_t)MT * 4), c4 = *(const f32x4*)(q + (size_t)MT * 8), d4 = *(const f32x4*)(q + (size_t)MT * 12);
        const float s = ((a[0] + a[1]) + (a[2] + a[3])) + ((b4[0] + b4[1]) + (b4[2] + b4[3])) + ((c4[0] + c4[1]) + (c4[2] + c4[3])) + ((d4[0] + d4[1]) + (d4[2] + d4[3]));
        rinv[tid] = __builtin_amdgcn_rsqf(s * (1.f / 1024.f) + EPS); }
    __syncthreads();
    for (int i = 0; i < nrows / 16; ++i) {
        const int c = tid + 512 * i, s = c >> 5, c8 = c & 31;
        const u32x4 raw = *(const u32x4*)(AV + (size_t)(row0 + s) * DM + g * 256 + c8 * 8);
        const float ri = rinv[s];
        const f32x4 g0 = *(const f32x4*)(vng + g * 256 + c8 * 8), g1 = *(const f32x4*)(vng + g * 256 + c8 * 8 + 4);
        f32x4 x0, x1;
        x0[0] = bf2f(raw.x & 0xffffu) * ri * g0[0]; x0[1] = bf2f(raw.x >> 16) * ri * g0[1]; x0[2] = bf2f(raw.y & 0xffffu) * ri * g0[2]; x0[3] = bf2f(raw.y >> 16) * ri * g0[3];
        x1[0] = bf2f(raw.z & 0xffffu) * ri * g1[0]; x1[1] = bf2f(raw.z >> 16) * ri * g1[1]; x1[2] = bf2f(raw.w & 0xffffu) * ri * g1[2]; x1[3] = bf2f(raw.w >> 16) * ri * g1[3];
        if (mlpv) { *(f32x4*)(mlpv + (size_t)s * DM + g * 256 + c8 * 8) = x0; *(f32x4*)(mlpv + (size_t)s * DM + g * 256 + c8 * 8 + 4) = x1; }
        u32x4 pw; pw.x = pk2(x0[0], x0[1]); pw.y = pk2(x0[2], x0[3]); pw.z = pk2(x1[0], x1[1]); pw.w = pk2(x1[2], x1[3]);
        *(LAS u32x4*)(lds + s * XP + c8 * 16) = pw;
    }
    __syncthreads();
    const int tb = w & 3, chalf = w >> 2;
    if (tb * 32 < nrows) {
        f32x16 acc[4];
#pragma unroll
        for (int cb = 0; cb < 4; ++cb)
#pragma unroll
            for (int i = 0; i < 16; ++i) acc[cb][i] = 0.f;
        const int q4 = (lane & 15) >> 2, pp = lane & 3, blk = (lane >> 4) & 1;
        const bf16_t* wrow = WsB + (size_t)(32 * tb + r) * 128 + 8 * hh;
        const LAS unsigned char* xb = lds + (8 * hh + q4) * XP + (chalf * 128 + blk * 16) * 2 + pp * 8;
        const int nks = 2 * (tb + 1);
        for (int ks = 0; ks < nks; ++ks) {
            const bf16x8 wb = *(const bf16x8*)(wrow + 16 * ks);
#pragma unroll
            for (int cb = 0; cb < 4; ++cb) {
                const s16x4 lo = trr(xb + ks * 16 * XP + cb * 64), hi = trr(xb + ks * 16 * XP + 4 * XP + cb * 64);
                const bf16x8 xa = __builtin_shufflevector(lo, hi, 0, 1, 2, 3, 4, 5, 6, 7);
                acc[cb] = MFMA32(xa, wb, acc[cb]);
            }
        }
        const int t = 32 * tb + r; const float bs = bsg[t]; const size_t ro = (size_t)(row0 + t) * DM + g * 256 + chalf * 128;
#pragma unroll
        for (int cb = 0; cb < 4; ++cb)
#pragma unroll
            for (int gq = 0; gq < 4; ++gq) {
                const size_t idx = ro + cb * 32 + 8 * gq + 4 * hh;
                const u32x2 uz = *(const u32x2*)(UZ + idx);
                u32x2 ow;
                ow.x = pk2((acc[cb][4 * gq + 0] + bs) * bf2f(uz.x & 0xffffu), (acc[cb][4 * gq + 1] + bs) * bf2f(uz.x >> 16));
                ow.y = pk2((acc[cb][4 * gq + 2] + bs) * bf2f(uz.y & 0xffffu), (acc[cb][4 * gq + 3] + bs) * bf2f(uz.y >> 16));
                *(u32x2*)(YA + idx) = ow;
            }
    }
    __syncthreads();
}
#ifndef ATT_REPS
#define ATT_REPS 1
#endif
#ifndef LIGHT_REPS
#define LIGHT_REPS 1
#endif
#ifndef P1_REPS
#define P1_REPS 1
#endif
#ifndef CONVERT_IN_LOOP
#define CONVERT_IN_LOOP 0
#endif
#ifndef CONVERT_AT_END
#define CONVERT_AT_END 0
#endif
#ifndef SKIP_P0
#define SKIP_P0 0
#endif
#ifndef SKIP_P1
#define SKIP_P1 0
#endif
#ifndef SKIP_P2
#define SKIP_P2 0
#endif
#ifndef SKIP_P3A
#define SKIP_P3A 0
#endif
#ifndef SKIP_P3B
#define SKIP_P3B 0
#endif
typedef const __attribute__((address_space(4))) Params* KArgs;
__device__ __forceinline__ KArgs kargs() { KArgs k = (KArgs)__builtin_amdgcn_kernarg_segment_ptr(); asm volatile("" : "+s"(k)); return k; }
#define KP_DECL() KArgs kp = kargs(); float* ctl = (float*)(kp->ws + WS_CTL); bf16_t* act = (bf16_t*)(kp->ws + WS_ACT); bf16_t* XB = (bf16_t*)(kp->ws + WS_XB); float* X1 = (float*)(kp->ws + WS_X1); (void)ctl; (void)act; (void)XB; (void)X1
__global__ void __launch_bounds__(512, 2) fwd_kernel(Params p) {
    extern __shared__ __attribute__((aligned(16))) unsigned char lds_raw[];
    LAS unsigned char* lds = (LAS unsigned char*)lds_raw;
    cg::grid_group grid = cg::this_grid();
    const int G = gridDim.x, bx = blockIdx.x;
    const int vcu = (G % 8 == 0) ? (bx % 8) * (G / 8) + bx / 8 : bx;
    int ph = 0;
#define PH_IN() (p.ph_lo <= ph && ph < p.ph_hi)
#define PH_END() do { if (p.ph_lo <= ph && ph + 1 < p.ph_hi) { \
        asm volatile("s_waitcnt vmcnt(0) lgkmcnt(0)" ::: "memory");                   \
        __syncthreads(); \
        if ((threadIdx.x >> 6) == 0) { __builtin_amdgcn_fence(__ATOMIC_RELEASE, "agent"); asm volatile("s_waitcnt vmcnt(0)" ::: "memory"); }     \
        grid.sync(); \
        if ((threadIdx.x >> 6) == 0) { __builtin_amdgcn_fence(__ATOMIC_ACQUIRE, "agent"); asm volatile("s_waitcnt vmcnt(0)" ::: "memory"); }     \
        __syncthreads();                                                                                                                         \
    } ++ph; } while (0)
    if (PH_IN() && !SKIP_P0) { KArgs kp = kargs(); phase_prologue(kp, lds); }
    PH_END();
#pragma unroll 1
    for (int li = 0; li < 2; ++li) {
        if (PH_IN() && !SKIP_P1) {
            KP_DECL(); float* xssq_cur = (float*)(kp->ws + WS_PART) + (size_t)li * MT * 16; float* avssq = (float*)(kp->ws + WS_PART) + (size_t)(2 + li) * MT * 16;
            pg8::Gemm g{li == 0 ? XB : (const bf16_t*)(kp->ws + WS_XB1), (const bf16_t*)(kp->ws + WS_WIN) + (size_t)li * DIN * DM, MT, DIN, DM};
            pg8::StaticOrder S; S.init(MT, DIN, G, bx);
            pg8::EpiIn E{xssq_cur, avssq, act, kp->out + O_KP + (size_t)li * MP * DM, kp->out + O_VP + (size_t)li * MP * DM, kp->out + O_KS + (size_t)li * MS * DM, kp->out + O_VS + (size_t)li * MS * DM};
            for (int rep = 0; rep < P1_REPS; ++rep) pg8::gemm_phase<pg8::EpiIn, pg8::StaticOrder, true, true>(lds, g, S, E);
        }
        PH_END();
        if (PH_IN() && !SKIP_P2) {
            KP_DECL(); float* avssq = (float*)(kp->ws + WS_PART) + (size_t)(2 + li) * MT * 16;
            AttnArgs A;
            A.QB = act + A_QB * ACT; A.KB = act + A_KB * ACT; A.VB = act + A_VB * ACT; A.BZ = act + A_BZ * ACT; A.YB = act + A_YB * ACT;
            A.ck = kp->in[2] + (size_t)li * DBATCH * PAST * DM; A.cv = kp->in[3] + (size_t)li * DBATCH * PAST * DM;
            A.nks = kp->out + O_KS + (size_t)li * MS * DM; A.nvs = kp->out + O_VS + (size_t)li * MS * DM;
            A.ang = kp->in[13] + li * 128; A.lam = ctl[li]; A.post = 1.f - (0.8f - 0.6f * expf(-0.3f * (float)li));
            if (CONVERT_IN_LOOP) {
                const unsigned* kb = (const unsigned*)(act + A_KB * ACT); const unsigned* vb = (const unsigned*)(act + A_VB * ACT);
                float* ko = kp->out + O_KP + (size_t)li * MP * DM; float* vo = kp->out + O_VP + (size_t)li * MP * DM;
                float* kso = kp->out + O_KS + (size_t)li * MS * DM; float* vso = kp->out + O_VS + (size_t)li * MS * DM;
                int ct_ = threadIdx.x, cb_ = blockIdx.x, cg_ = gridDim.x; asm volatile("" : "+v"(ct_), "+s"(cb_), "+s"(cg_));
                for (size_t i = (size_t)cb_ * 512 + ct_; i < (size_t)MT * DM / 8; i += (size_t)cg_ * 512) {
                    const u32x4 a = *(const u32x4*)(kb + 4 * i), c4 = *(const u32x4*)(vb + 4 * i);
                    const size_t e = 8 * i;
                    float* kd = e < (size_t)MP * DM ? ko + e : kso + (e - (size_t)MP * DM);
                    float* vd = e < (size_t)MP * DM ? vo + e : vso + (e - (size_t)MP * DM);
                    *(f32x4*)kd = (f32x4){bf2f(a.x & 0xffffu), bf2f(a.x >> 16), bf2f(a.y & 0xffffu), bf2f(a.y >> 16)}; *(f32x4*)(kd + 4) = (f32x4){bf2f(a.z & 0xffffu), bf2f(a.z >> 16), bf2f(a.w & 0xffffu), bf2f(a.w >> 16)};
#ifdef CONVERT_K_ONLY
                    if (li == 0)
#endif
                    { *(f32x4*)vd = (f32x4){bf2f(c4.x & 0xffffu), bf2f(c4.x >> 16), bf2f(c4.y & 0xffffu), bf2f(c4.y >> 16)}; *(f32x4*)(vd + 4) = (f32x4){bf2f(c4.z & 0xffffu), bf2f(c4.z >> 16), bf2f(c4.w & 0xffffu), bf2f(c4.w >> 16)}; }
                }
            }
#ifdef P2L1_CONVERT_ONLY
            if (li == 0) {
#else
            {
#endif
            const int per = (1024 + G - 1) / G;
            for (int rep = 0; rep < ATT_REPS; ++rep)
            for (int it = vcu * per; it < (vcu + 1) * per && it < 1024; ++it) {
                const int bh = it >> 4, j = it & 15;
#ifndef SKIP_PA
                attn_unit<false>(lds, A, bh >> 3, bh & 7, j);
                attn_unit<false>(lds, A, bh >> 3, bh & 7, 31 - j);
#endif
            }
            const bool split = (G >= 256);
            for (int lrep = 0; lrep < LIGHT_REPS; ++lrep)
            for (int it = split ? (vcu < 128 ? vcu : 128 + (vcu - 128)) : vcu; it < 128 + 1024 + 64; it += split ? (vcu < 128 ? 1 << 30 : (G - 128)) : G) {
                if (it < 128) {
#ifndef SKIP_SA
                    attn_unit<true>(lds, A, it >> 3, it & 7, 0);
#endif
                }
                else if (it < 1152) { const int sp = it - 128, ch = sp >> 2, g = sp & 3;
                    spatial_unit(lds, ch * 128, 128, g, act + A_AV * ACT, act + A_UZ * ACT, act + A_YA * ACT, avssq, (const bf16_t*)(kp->ws + WS_WSB) + (size_t)(li * 4 + g) * 128 * 128,
                                 kp->in[7] + (li * 4 + g) * 128, kp->in[8] + li * DM, nullptr); }
                else { const int sp = it - 1152, b = sp >> 2, g = sp & 3;
                    spatial_unit(lds, MP + b * DSEQ, 64, g, act + A_AV * ACT, act + A_UZ * ACT, act + A_YA * ACT, avssq, (const bf16_t*)(kp->ws + WS_WSB) + (size_t)(li * 4 + g) * 128 * 128,
                                 kp->in[7] + (li * 4 + g) * 128, kp->in[8] + li * DM, kp->out + O_MV + ((size_t)li * MS + (size_t)b * DSEQ) * DM); }
            }
            }
        }
        PH_END();
        if (PH_IN() && !SKIP_P3A) {
            KP_DECL();
            pg8::StaticOrder S; S.init(MT, DM, G, bx);
            { pg8::Gemm g{act + A_YA * ACT, (const bf16_t*)(kp->ws + WS_WPA) + (size_t)li * DM * DM, MT, DM, DM};
#ifdef SKIP_G2
              pg8::EpiGate<0> E{act + A_SGA * ACT, nullptr, act + A_AV * ACT};
#else
              pg8::EpiGate<0> E{act + A_SGA * ACT, nullptr, act + A_UZ * ACT};
#endif
              pg8::gemm_phase<pg8::EpiGate<0>, pg8::StaticOrder, true, true>(lds, g, S, E); }
#ifndef SKIP_G2
            { pg8::Gemm g{act + A_YB * ACT, (const bf16_t*)(kp->ws + WS_WPB) + (size_t)li * DM * DM, MT, DM, DM};
              pg8::EpiGate<1> E{act + A_SGB * ACT, act + A_UZ * ACT, act + A_AV * ACT};
              pg8::gemm_phase<pg8::EpiGate<1>, pg8::StaticOrder, true, true>(lds, g, S, E); }
#endif
        }
        PH_END();
        if (PH_IN() && !SKIP_P3B) {
            KP_DECL();
            pg8::StaticOrder S; S.init(MT, DM, G, bx);
            pg8::Gemm g{act + A_AV * ACT, (const bf16_t*)(kp->ws + WS_WOUT) + (size_t)li * DM * DM, MT, DM, DM};
            pg8::EpiRes E{li == 0 ? kp->in[0] : X1, li == 0 ? kp->in[1] : X1 + (size_t)MP * DM, X1, (bf16_t*)(kp->ws + WS_XB1), (float*)(kp->ws + WS_PART) + (size_t)MT * 16, li == 0 ? 1 : 0};
            pg8::gemm_phase<pg8::EpiRes, pg8::StaticOrder, true, true>(lds, g, S, E);
        }
        PH_END();
    }
#ifdef DUMP_OFF
    {
        __builtin_amdgcn_fence(__ATOMIC_RELEASE, "agent"); asm volatile("s_waitcnt vmcnt(0) lgkmcnt(0)" ::: "memory"); grid.sync(); __builtin_amdgcn_fence(__ATOMIC_ACQUIRE, "agent"); asm volatile("s_waitcnt vmcnt(0) lgkmcnt(0)" ::: "memory");
        KP_DECL();
        const unsigned* srcb = (const unsigned*)(kp->ws + (size_t)(DUMP_OFF));
#ifdef DUMP_WIDE
        {
            float* ko = kp->out + O_KP + (size_t)MP * DM; float* kso = kp->out + O_KS + (size_t)MS * DM;
            for (size_t i = (size_t)bx * 512 + threadIdx.x; i < (size_t)MT * DM / 8; i += (size_t)G * 512) {
                const u32x4 a = *(const u32x4*)(srcb + 4 * i);
                const size_t e = 8 * i;
                float* kd = e < (size_t)MP * DM ? ko + e : kso + (e - (size_t)MP * DM);
                *(f32x4*)kd = (f32x4){bf2f(a.x & 0xffffu), bf2f(a.x >> 16), bf2f(a.y & 0xffffu), bf2f(a.y >> 16)}; *(f32x4*)(kd + 4) = (f32x4){bf2f(a.z & 0xffffu), bf2f(a.z >> 16), bf2f(a.w & 0xffffu), bf2f(a.w >> 16)};
            }
        }
#else
        for (size_t i = (size_t)bx * 512 + threadIdx.x; i < (size_t)MT * DM / 2; i += (size_t)G * 512) {
#ifdef DUMP_F32
            if (i < (size_t)DUMP_F32) kp->out[O_YP + i] = ((const float*)srcb)[i];
#else
            const unsigned v = srcb[i];
            if (i < (size_t)MP * DM / 2) { kp->out[O_KP + (size_t)MP * DM + 2 * i] = bf2f(v & 0xffffu); kp->out[O_KP + (size_t)MP * DM + 2 * i + 1] = bf2f(v >> 16); }
            else { const size_t j = i - (size_t)MP * DM / 2; kp->out[O_KS + (size_t)MS * DM + 2 * j] = bf2f(v & 0xffffu); kp->out[O_KS + (size_t)MS * DM + 2 * j + 1] = bf2f(v >> 16); }
#endif
        }
#endif
    }
#endif
    if (PH_IN()) {
        KP_DECL();
        if (CONVERT_AT_END) {
            const unsigned* kb = (const unsigned*)(act + A_KB * ACT); const unsigned* vb = (const unsigned*)(act + A_VB * ACT);
            float* ko = kp->out + O_KP + (size_t)MP * DM; float* vo = kp->out + O_VP + (size_t)MP * DM;
            float* kso = kp->out + O_KS + (size_t)MS * DM; float* vso = kp->out + O_VS + (size_t)MS * DM;
            for (size_t i = (size_t)bx * 512 + threadIdx.x; i < (size_t)MT * DM / 8; i += (size_t)G * 512) {
                const u32x4 a = *(const u32x4*)(kb + 4 * i), c4 = *(const u32x4*)(vb + 4 * i);
                const size_t e = 8 * i;
                float* kd = e < (size_t)MP * DM ? ko + e : kso + (e - (size_t)MP * DM);
                float* vd = e < (size_t)MP * DM ? vo + e : vso + (e - (size_t)MP * DM);
                *(f32x4*)kd = (f32x4){bf2f(a.x & 0xffffu), bf2f(a.x >> 16), bf2f(a.y & 0xffffu), bf2f(a.y >> 16)}; *(f32x4*)(kd + 4) = (f32x4){bf2f(a.z & 0xffffu), bf2f(a.z >> 16), bf2f(a.w & 0xffffu), bf2f(a.w >> 16)};
                *(f32x4*)vd = (f32x4){bf2f(c4.x & 0xffffu), bf2f(c4.x >> 16), bf2f(c4.y & 0xffffu), bf2f(c4.y >> 16)}; *(f32x4*)(vd + 4) = (f32x4){bf2f(c4.z & 0xffffu), bf2f(c4.z >> 16), bf2f(c4.w & 0xffffu), bf2f(c4.w >> 16)};
            }
        }
        int tid_ = threadIdx.x; asm volatile("" : "+v"(tid_)); const int lane = tid_ & 63, wave = tid_ >> 6;
        const int gw = bx * 8 + wave, NGW = G * 8;
        const float* gf = kp->in[17];
        f32x4 gv[4];
#pragma unroll
        for (int j = 0; j < 4; ++j) gv[j] = *(const f32x4*)(gf + 256 * j + 4 * lane);
        for (int m = gw; m < MT; m += NGW) {
            const float* xr = X1 + (size_t)m * DM;
            f32x4 v[4]; float s = 0.f;
#pragma unroll
            for (int j = 0; j < 4; ++j) { v[j] = *(const f32x4*)(xr + 256 * j + 4 * lane); s += v[j][0] * v[j][0] + v[j][1] * v[j][1] + v[j][2] * v[j][2] + v[j][3] * v[j][3]; }
            s = wave_sum(s);
            const float ri = 1.0f / sqrtf(s * (1.f / 1024.f) + EPS);
            float* orow = m < MP ? kp->out + O_YP + (size_t)m * DM : kp->out + O_YS + (size_t)(m - MP) * DM;
#pragma unroll
            for (int j = 0; j < 4; ++j) *(f32x4*)(orow + 256 * j + 4 * lane) = v[j] * ri * gv[j];
        }
    }
}

#ifndef PH_HI
#define PH_HI 100
#endif
#ifndef N_LAUNCH_MODE
#define N_LAUNCH_MODE 1
#endif
extern "C" void kernel_launch(void* const* d_in, const int* in_sizes, int n_in, void* d_out, int out_size, void* d_ws, size_t ws_size, hipStream_t stream) {
    static int grid = 0;
    if (grid == 0) {
        if (n_in != 18 || ws_size < WS_END) { fprintf(stderr, "kernel_launch: unexpected n_in %d / ws %zu (need %zu)\n", n_in, ws_size, (size_t)WS_END); grid = -1; return; }
        int dev = 0, cus = 0, per_cu = 0;
        hipGetDevice(&dev); hipDeviceGetAttribute(&cus, hipDeviceAttributeMultiprocessorCount, dev);
        if (hipFuncSetAttribute((const void*)fwd_kernel, hipFuncAttributeMaxDynamicSharedMemorySize, LDS_BYTES) != hipSuccess) { fprintf(stderr, "kernel_launch: hipFuncSetAttribute failed\n"); grid = -1; return; }
        if (hipOccupancyMaxActiveBlocksPerMultiprocessor(&per_cu, (const void*)fwd_kernel, 512, LDS_BYTES) != hipSuccess || per_cu < 1) { fprintf(stderr, "kernel_launch: occupancy query says %d\n", per_cu); per_cu = 1; }
        (void)hipGetLastError();
        grid = cus * 1;
    }
    if (grid < 0) return;
    Params p{};
    for (int i = 0; i < 18; ++i) p.in[i] = (const float*)d_in[i];
    p.out = (float*)d_out; p.ws = (unsigned char*)d_ws;
#if N_LAUNCH_MODE == 1
    p.ph_lo = 0; p.ph_hi = PH_HI;
    void* args[] = {&p};
    hipError_t e = hipLaunchCooperativeKernel((const void*)fwd_kernel, dim3(grid), dim3(512), args, LDS_BYTES, stream);
    if (e != hipSuccess) fprintf(stderr, "cooperative launch failed: %s (grid %d)\n", hipGetErrorString(e), grid);
#else
    for (int ph = 0; ph < 10 && ph < PH_HI; ++ph) { p.ph_lo = ph; p.ph_hi = ph + 1; hipLaunchKernelGGL(fwd_kernel, dim3(grid), dim3(512), LDS_BYTES, stream, p); }
#endif
}
```
